# Optimizing an MI355X kernel written in HIP

```python
import jax, jax.numpy as jnp
from jax import lax
import numpy as np

D_MODEL = 1024
BATCH = 32
SEQ = 2048
DEPTH = 1

RET_HEADS = 4
RET_DK = 128
RET_DV = 256
RET_CHUNK = 128
FOX_HEADS = 8
FOX_DH = 64
FOX_BLOCK = 128
PEER_HEADS = 8
PEER_NKEYS = 128
PEER_NEXP = PEER_NKEYS * PEER_NKEYS
PEER_DQ = 256
PEER_HALF = PEER_DQ // 2
PEER_TOPK = 16
PEER_TOK_BLOCK = 128
PLE_DIM = 256
LN_EPS = 1e-5
ROPE_BASE = 10000.0
ALPHA = (2.0 * DEPTH) ** 0.25
BETA = (8.0 * DEPTH) ** -0.25

RET_QK_W = RET_HEADS * RET_DK
RET_V_W = RET_HEADS * RET_DV
FOX_W = FOX_HEADS * FOX_DH
IN_SPLITS = (RET_QK_W, RET_QK_W, RET_V_W, RET_V_W, FOX_W, FOX_W, FOX_W, FOX_HEADS, D_MODEL, D_MODEL)
N_IN = sum(IN_SPLITS)

kernel_name = "hybrid_retention_fox_peer_deepnorm"


def layer_norm(x, g, b):
    xf = x.astype(jnp.float32)
    mu = jnp.mean(xf, axis=-1, keepdims=True)
    var = jnp.mean(jnp.square(xf - mu), axis=-1, keepdims=True)
    y = (xf - mu) * lax.rsqrt(var + LN_EPS)
    return (y * g.astype(jnp.float32) + b.astype(jnp.float32)).astype(x.dtype)


def group_norm_heads(y):
    mu = jnp.mean(y, axis=-1, keepdims=True)
    var = jnp.mean(jnp.square(y - mu), axis=-1, keepdims=True)
    return (y - mu) * lax.rsqrt(var + LN_EPS)


def rotary(x, pos):
    d = x.shape[-1]
    half = d // 2
    inv = ROPE_BASE ** (-jnp.arange(half, dtype=jnp.float32) / half)
    ang = pos.astype(jnp.float32)[:, None] * inv[None, :]
    cos = jnp.cos(ang)[None, :, None, :]
    sin = jnp.sin(ang)[None, :, None, :]
    xf = x.astype(jnp.float32)
    x1, x2 = xf[..., :half], xf[..., half:]
    return jnp.concatenate([x1 * cos - x2 * sin, x2 * cos + x1 * sin], axis=-1)


def retention(q, k, v):
    B, S, H, dk = q.shape
    dv = v.shape[-1]
    C = RET_CHUNK
    n = S // C
    log_g = jnp.log(1.0 - 2.0 ** (-5.0 - jnp.arange(H, dtype=jnp.float32)))
    idx = jnp.arange(C, dtype=jnp.float32)
    diff = idx[:, None] - idx[None, :]
    intra = jnp.where(diff >= 0, jnp.exp(log_g[:, None, None] * jnp.maximum(diff, 0.0)), 0.0)
    q_decay = jnp.exp(log_g[:, None] * (idx + 1.0))[..., None]
    k_decay = jnp.exp(log_g[:, None] * (C - 1.0 - idx))[..., None]
    chunk_decay = jnp.exp(log_g * C)[:, None, None]

    def to_chunks(t):
        return t.reshape(B, n, C, H, t.shape[-1]).transpose(1, 0, 3, 2, 4)

    qc, kc, vc = to_chunks(q), to_chunks(k), to_chunks(v)

    def step(R, inp):
        qi, ki, vi = inp
        s = jnp.einsum('bhid,bhjd->bhij', qi, ki) * intra
        inner = jnp.einsum('bhij,bhjv->bhiv', s, vi)
        cross = jnp.einsum('bhid,bhdv->bhiv', qi * q_decay, R)
        R_new = chunk_decay * R + jnp.einsum('bhjd,bhjv->bhdv', ki * k_decay, vi)
        return R_new, inner + cross

    R0 = jnp.zeros((B, H, dk, dv), jnp.float32)
    _, out = lax.scan(step, R0, (qc, kc, vc))
    return out.transpose(1, 0, 3, 2, 4).reshape(B, S, H, dv)


def forgetting_attention(q, k, v, log_f):
    B, S, H, d = q.shape
    nb = S // FOX_BLOCK
    c = jnp.cumsum(log_f, axis=1).transpose(0, 2, 1)
    qh = q.transpose(0, 2, 1, 3)
    kh = k.transpose(0, 2, 1, 3)
    vh = v.transpose(0, 2, 1, 3)
    qb = qh.reshape(B, H, nb, FOX_BLOCK, d).transpose(2, 0, 1, 3, 4)
    cb = c.reshape(B, H, nb, FOX_BLOCK).transpose(2, 0, 1, 3)
    starts = jnp.arange(nb, dtype=jnp.int32) * FOX_BLOCK
    kpos = jnp.arange(S, dtype=jnp.int32)
    scale = d ** -0.5

    def block(inp):
        qi, ci, start = inp
        qpos = start + jnp.arange(FOX_BLOCK, dtype=jnp.int32)
        logits = jnp.einsum('bhqd,bhkd->bhqk', qi, kh).astype(jnp.float32) * scale
        logits = logits + ci[..., None] - c[:, :, None, :]
        logits = jnp.where(kpos[None, :] <= qpos[:, None], logits, -1e30)
        probs = jax.nn.softmax(logits, axis=-1)
        return jnp.einsum('bhqk,bhkd->bhqd', probs.astype(vh.dtype), vh)

    out = lax.map(block, (qb, cb, starts))
    return out.transpose(1, 0, 3, 2, 4).reshape(B, S, H * d)


def peer(x, w_q, sub_keys, expert_u, expert_v):
    B, S, D = x.shape
    nt = (B * S) // PEER_TOK_BLOCK
    xt = x.reshape(nt, PEER_TOK_BLOCK, D)

    def block(xc):
        n = xc.shape[0]
        q = (xc @ w_q).reshape(n, PEER_HEADS, 2, PEER_HALF)
        sc = jnp.einsum('nhcd,hckd->nhck', q, sub_keys).astype(jnp.float32)
        s, idx = lax.top_k(sc, PEER_TOPK)
        cand = (s[:, :, 0, :, None] + s[:, :, 1, None, :]).reshape(n, PEER_HEADS, PEER_TOPK * PEER_TOPK)
        cid = (idx[:, :, 0, :, None] * PEER_NKEYS + idx[:, :, 1, None, :]).reshape(n, PEER_HEADS, PEER_TOPK * PEER_TOPK)
        top_s, pos = lax.top_k(cand, PEER_TOPK)
        eid = jnp.take_along_axis(cid, pos, axis=-1)
        gate = jax.nn.softmax(top_s, axis=-1)
        u = expert_u[eid]
        hid = jnp.einsum('nhkd,nd->nhk', u, xc).astype(jnp.float32)
        act = (jax.nn.gelu(hid, approximate=False) * gate).astype(xc.dtype)
        return jnp.einsum('nhk,nhkd->nd', act, expert_v[eid])

    return lax.map(block, xt).reshape(B, S, D)


def setup_inputs(seed: int = 0) -> dict:
    key = jax.random.key(seed)
    ks = jax.random.split(key, 24)
    f32 = jnp.float32
    D = D_MODEL
    nrm = lambda k, shape, s: jax.random.normal(k, shape, f32) * s
    return {
        "x": nrm(ks[0], (BATCH, SEQ, D), 1.0),
        "p": nrm(ks[1], (DEPTH, BATCH, SEQ, PLE_DIM), 1.0),
        "ln_emb_g": 1.0 + nrm(ks[2], (D,), 0.02),
        "ln_emb_b": nrm(ks[3], (D,), 0.02),
        "w_in": nrm(ks[4], (DEPTH, D, N_IN), D ** -0.5),
        "b_forget": 2.0 + nrm(ks[5], (DEPTH, FOX_HEADS), 0.5),
        "b_branch_gate": nrm(ks[6], (DEPTH, 2, D), 0.02),
        "w_ret_o": nrm(ks[7], (DEPTH, RET_V_W, D), RET_V_W ** -0.5),
        "w_fox_o": nrm(ks[8], (DEPTH, FOX_W, D), FOX_W ** -0.5),
        "w_out": nrm(ks[9], (DEPTH, D, D), BETA * D ** -0.5),
        "ln1_g": 1.0 + nrm(ks[10], (DEPTH, D), 0.02),
        "ln1_b": nrm(ks[11], (DEPTH, D), 0.02),
        "w_peer_q": nrm(ks[12], (DEPTH, D, PEER_HEADS * PEER_DQ), D ** -0.5),
        "peer_sub_keys": nrm(ks[13], (DEPTH, PEER_HEADS, 2, PEER_NKEYS, PEER_HALF), PEER_HALF ** -0.5),
        "peer_u": nrm(ks[14], (DEPTH, PEER_NEXP, D), D ** -0.5),
        "peer_v": nrm(ks[15], (DEPTH, PEER_NEXP, D), BETA * PEER_HEADS ** -0.5),
        "w_ple_gate": nrm(ks[16], (DEPTH, D, D), D ** -0.5),
        "b_ple_gate": nrm(ks[17], (DEPTH, D), 0.02),
        "w_ple": nrm(ks[18], (DEPTH, PLE_DIM, D), BETA * PLE_DIM ** -0.5),
        "ln2_g": 1.0 + nrm(ks[19], (DEPTH, D), 0.02),
        "ln2_b": nrm(ks[20], (DEPTH, D), 0.02),
    }


def reference(x, p, ln_emb_g, ln_emb_b, w_in, b_forget, b_branch_gate, w_ret_o, w_fox_o, w_out,
              ln1_g, ln1_b, w_peer_q, peer_sub_keys, peer_u, peer_v, w_ple_gate, b_ple_gate, w_ple,
              ln2_g, ln2_b):
    B, S, _ = x.shape
    pos = jnp.arange(S, dtype=jnp.int32)
    split_points = np.cumsum(np.array(IN_SPLITS))[:-1].tolist()
    h = layer_norm(x, ln_emb_g, ln_emb_b)
    for i in range(DEPTH):
        proj = h @ w_in[i]
        rq, rk, rv, rg, fq, fk, fv, ff, gr, gf = jnp.split(proj, split_points, axis=-1)
        q_r = rotary(rq.reshape(B, S, RET_HEADS, RET_DK), pos)
        k_r = rotary(rk.reshape(B, S, RET_HEADS, RET_DK), pos) * (RET_DK ** -0.5)
        v_r = rv.reshape(B, S, RET_HEADS, RET_DV).astype(jnp.float32)
        y_r = group_norm_heads(retention(q_r, k_r, v_r)).reshape(B, S, RET_V_W).astype(h.dtype)
        y_ret = (jax.nn.silu(rg) * y_r) @ w_ret_o[i]
        log_f = jax.nn.log_sigmoid(ff.astype(jnp.float32) + b_forget[i].astype(jnp.float32))
        y_f = forgetting_attention(fq.reshape(B, S, FOX_HEADS, FOX_DH),
                                   fk.reshape(B, S, FOX_HEADS, FOX_DH),
                                   fv.reshape(B, S, FOX_HEADS, FOX_DH), log_f)
        y_fox = y_f.astype(h.dtype) @ w_fox_o[i]
        merged = jax.nn.sigmoid(gr + b_branch_gate[i, 0]) * y_ret + jax.nn.sigmoid(gf + b_branch_gate[i, 1]) * y_fox
        h = layer_norm(ALPHA * h + merged @ w_out[i], ln1_g[i], ln1_b[i])
        ple = jax.nn.sigmoid(h @ w_ple_gate[i] + b_ple_gate[i]) * (p[i] @ w_ple[i])
        ch = peer(h, w_peer_q[i], peer_sub_keys[i], peer_u[i], peer_v[i]) + ple
        h = layer_norm(ALPHA * h + ch, ln2_g[i], ln2_b[i])
    return h
```

```cpp
#include <hip/hip_runtime.h>
#include <hip/hip_cooperative_groups.h>
#include <cstdio>
namespace cg = cooperative_groups;

typedef unsigned short u16;
typedef short bf16x8 __attribute__((ext_vector_type(8)));
typedef float f32x16 __attribute__((ext_vector_type(16)));
typedef float f32x4 __attribute__((ext_vector_type(4)));
typedef unsigned u32x4 __attribute__((ext_vector_type(4)));
typedef unsigned u32x2 __attribute__((ext_vector_type(2)));
#define DI __device__ __forceinline__
#define MFMA32(a, b, c) __builtin_amdgcn_mfma_f32_32x32x16_bf16((a), (b), (c), 0, 0, 0)
#define MFMA16(a, b, c) __builtin_amdgcn_mfma_f32_16x16x32_bf16((a), (b), (c), 0, 0, 0)

constexpr int NTHR = 512;
constexpr float ALPHA = 1.189207115002721f;
constexpr float LN_EPS = 1e-5f;
constexpr size_t MB = 1u << 20;
constexpr size_t O_WIN = 0, O_WGF = 9 * MB, O_WGR = 11 * MB, O_WRO = 13 * MB, O_WFO = 15 * MB, O_WO = 16 * MB,
                 O_WQ = 18 * MB, O_WG = 22 * MB, O_WPLE = 24 * MB, O_KEYS = 24 * MB + MB / 2, O_ROPE = 25 * MB,
                 O_LOGF = 26 * MB, O_CTR = 28 * MB, O_U = 32 * MB, O_V = 64 * MB, O_PB = 96 * MB, O_H0 = 128 * MB,
                 O_QR = 256 * MB, O_KR = 320 * MB, O_VT = 384 * MB, O_KTD = 512 * MB, O_FK = 576 * MB,
                 O_RG = 640 * MB, O_FQ = 768 * MB, O_FVT = 832 * MB;
constexpr size_t O_YF = 960 * MB;
constexpr size_t O_X8 = 896 * MB;
constexpr size_t O_MERGED = O_QR, O_PRE1 = O_VT, O_H1B = O_H0, O_PLE = O_RG, O_EID = O_FVT, O_GATE = O_FVT + 32 * MB;
constexpr int L_STG = 65536, L_Q2 = 0, L_WFF = 98304, L_TOTAL = 151552;
constexpr int LDK = 72;
constexpr int LDQ = 136;
constexpr int LDQ2 = 264;

struct Params {
  const float *x, *p, *ln_emb_g, *ln_emb_b, *w_in, *b_forget, *b_bg, *w_ret_o, *w_fox_o, *w_out, *ln1_g, *ln1_b,
      *w_peer_q, *sub_keys, *peer_u, *peer_v, *w_ple_gate, *b_ple_gate, *w_ple, *ln2_g, *ln2_b;
  float* out;
  char* ws;
};

DI char* launder(char* p) {
  size_t z = 0;
  asm volatile("" : "+s"(z));
  return p + z;
}
DI int launder_tid() {
  int t = threadIdx.x;
  asm volatile("" : "+v"(t));
  return t;
}
DI float bf2f(u16 v) { return __uint_as_float((unsigned)v << 16); }
DI u16 f2bf(float x) {
  unsigned u = __float_as_uint(x);
  u += 0x7fffu + ((u >> 16) & 1u);
  return (u16)(u >> 16);
}
typedef __bf16 bf16v2 __attribute__((ext_vector_type(2)));
typedef float f32v2 __attribute__((ext_vector_type(2)));
DI unsigned pack2(float a, float b) {
  f32v2 v = {a, b};
  return __builtin_bit_cast(unsigned, __builtin_convertvector(v, bf16v2));
}
constexpr float U_SCALE = 64.f, V_SCALE = 16.f, X_SCALE = 8.f;
DI unsigned pack_fp8x4(float a, float b, float c, float d) {
  int w = __builtin_amdgcn_cvt_pk_fp8_f32(a, b, 0, false);
  w = __builtin_amdgcn_cvt_pk_fp8_f32(c, d, w, true);
  return (unsigned)w;
}
DI int crow(int i, int h) { return (i & 3) + 8 * (i >> 2) + 4 * h; }
DI float wave_sum(float v) {
  v += __int_as_float(__builtin_amdgcn_update_dpp(0, __float_as_int(v), 0xB1, 0xF, 0xF, true));
  v += __int_as_float(__builtin_amdgcn_update_dpp(0, __float_as_int(v), 0x4E, 0xF, 0xF, true));
  v += __int_as_float(__builtin_amdgcn_update_dpp(0, __float_as_int(v), 0x124, 0xF, 0xF, true));
  v += __int_as_float(__builtin_amdgcn_update_dpp(0, __float_as_int(v), 0x128, 0xF, 0xF, true));
  v += __shfl_xor(v, 16);
  v += __shfl_xor(v, 32);
  return v;
}
DI float half_sum(float v) {
#pragma unroll
  for (int o = 16; o; o >>= 1) v += __shfl_xor(v, o);
  return v;
}
DI float sigmoidf_(float x) { return 1.f / (1.f + __expf(-x)); }
DI bf16x8 pack8(const f32x16& x, int s) {
  u32x4 p;
  p[0] = pack2(x[8 * s + 0], x[8 * s + 1]);
  p[1] = pack2(x[8 * s + 2], x[8 * s + 3]);
  p[2] = pack2(x[8 * s + 4], x[8 * s + 5]);
  p[3] = pack2(x[8 * s + 6], x[8 * s + 7]);
  return __builtin_bit_cast(bf16x8, p);
}
DI bf16x8 ld8(const u16* p) { return *(const bf16x8*)p; }
DI bf16x8 join44(u32x2 a, u32x2 b) {
  u32x4 r = {a[0], a[1], b[0], b[1]};
  return __builtin_bit_cast(bf16x8, r);
}
DI void zero_acc(f32x16 (&acc)[2][2]) {
#pragma unroll
  for (int a = 0; a < 2; ++a)
#pragma unroll
    for (int b = 0; b < 2; ++b)
#pragma unroll
      for (int i = 0; i < 16; ++i) acc[a][b][i] = 0.f;
}

DI void glds16(const void* g, void* l) {
  __builtin_amdgcn_global_load_lds((const unsigned*)g, (__attribute__((address_space(3))) unsigned*)l, 16, 0, 0);
}
#define AN(mb, nb) acc[(mb) * 2 + (nb)]
#define AS(nb, mb) acc[(nb) * 4 + (mb)]
DI void zero_acc8(f32x16 (&acc)[8]) {
#pragma unroll
  for (int a = 0; a < 8; ++a)
#pragma unroll
    for (int i = 0; i < 16; ++i) acc[a][i] = 0.f;
}
template <bool SWAP>
DI void gemm_loop(const u16* __restrict__ A, int lda, const u16* __restrict__ B, int ldb, int K, char* smem,
                  f32x16 (&acc)[8]) {
  const int tid = launder_tid(), lane = tid & 63, w = tid >> 6, wr = w >> 2, wc = w & 3;
  const int lr = lane >> 3, slot = lane & 7;
  const int ce = (slot ^ (lr >> 1)) * 8, co = (slot ^ (4 + (lr >> 1))) * 8;
  const u16* ae = A + (size_t)(w * 32 + lr) * lda + ce;
  const u16* ao = A + (size_t)(w * 32 + lr) * lda + co;
  const u16* be = B + (size_t)(w * 32 + lr) * ldb + ce;
  const u16* bo = B + (size_t)(w * 32 + lr) * ldb + co;
#define AGP(j) (((j) & 1 ? ao : ae) + (size_t)((j) * 8) * lda)
#define BGP(j) (((j) & 1 ? bo : be) + (size_t)((j) * 8) * ldb)
  char* dA = smem + w * 4096;
  char* dB = smem + 32768 + w * 4096;
  const int nk = K >> 6;
  __syncthreads();
#pragma unroll
  for (int j = 0; j < 4; ++j) glds16(AGP(j), dA + j * 1024);
#pragma unroll
  for (int j = 0; j < 4; ++j) glds16(BGP(j), dB + j * 1024);
  const int ra_row = wr * 128 + (lane & 31), rb_row = wc * 64 + (lane & 31), hq = lane >> 5;
  const int sa = (ra_row >> 1) & 7, sb = (rb_row >> 1) & 7;
  const unsigned sbase = (unsigned)(size_t)smem;
  unsigned oa[4], ob[4];
#pragma unroll
  for (int ks = 0; ks < 4; ++ks) {
    oa[ks] = sbase + ra_row * 128 + (((ks * 2 + hq) ^ sa) << 4);
    ob[ks] = sbase + 32768 + rb_row * 128 + (((ks * 2 + hq) ^ sb) << 4);
  }
#define RD6(A0, A1, A2, A3, B0, B1, KS)                                                                            \
  asm volatile("ds_read_b128 %0, %6\n\tds_read_b128 %1, %6 offset:4096\n\tds_read_b128 %2, %6 offset:8192\n\t"     \
               "ds_read_b128 %3, %6 offset:12288\n\tds_read_b128 %4, %7\n\tds_read_b128 %5, %7 offset:4096"        \
               : "=&v"(A0), "=&v"(A1), "=&v"(A2), "=&v"(A3), "=&v"(B0), "=&v"(B1)                                  \
               : "v"(oa[KS] + so), "v"(ob[KS] + so)                                                                \
               : "memory")
#define WT6(A0, A1, A2, A3, B0, B1) \
  asm volatile("s_waitcnt lgkmcnt(0)" : "+v"(A0), "+v"(A1), "+v"(A2), "+v"(A3), "+v"(B0), "+v"(B1)::"memory")
#define MM8(A0, A1, A2, A3, B0, B1)             \
  if (SWAP) {                                   \
    AS(0, 0) = MFMA32(B0, A0, AS(0, 0));        \
    AS(0, 1) = MFMA32(B0, A1, AS(0, 1));        \
    AS(0, 2) = MFMA32(B0, A2, AS(0, 2));        \
    AS(0, 3) = MFMA32(B0, A3, AS(0, 3));        \
    AS(1, 0) = MFMA32(B1, A0, AS(1, 0));        \
    AS(1, 1) = MFMA32(B1, A1, AS(1, 1));        \
    AS(1, 2) = MFMA32(B1, A2, AS(1, 2));        \
    AS(1, 3) = MFMA32(B1, A3, AS(1, 3));        \
  } else {                                      \
    AN(0, 0) = MFMA32(A0, B0, AN(0, 0));        \
    AN(0, 1) = MFMA32(A0, B1, AN(0, 1));        \
    AN(1, 0) = MFMA32(A1, B0, AN(1, 0));        \
    AN(1, 1) = MFMA32(A1, B1, AN(1, 1));        \
    AN(2, 0) = MFMA32(A2, B0, AN(2, 0));        \
    AN(2, 1) = MFMA32(A2, B1, AN(2, 1));        \
    AN(3, 0) = MFMA32(A3, B0, AN(3, 0));        \
    AN(3, 1) = MFMA32(A3, B1, AN(3, 1));        \
  }
#pragma unroll 1
  for (int kt = 0; kt < nk; ++kt) {
    asm volatile("s_waitcnt vmcnt(0)" ::: "memory");
    asm volatile("s_waitcnt lgkmcnt(0)" ::: "memory");
    __builtin_amdgcn_s_barrier();
    if (kt + 1 < nk) {
      const int s2 = (kt + 1) & 1;
      const int ko = (kt + 1) * 64;
#pragma unroll
      for (int j = 0; j < 4; ++j) glds16(AGP(j) + ko, dA + s2 * L_STG + j * 1024);
#pragma unroll
      for (int j = 0; j < 4; ++j) glds16(BGP(j) + ko, dB + s2 * L_STG + j * 1024);
    }
    const unsigned so = (unsigned)((kt & 1) * L_STG);
    bf16x8 a0, a1, a2, a3, b0, b1;
#pragma unroll
    for (int ks = 0; ks < 4; ++ks) {
      RD6(a0, a1, a2, a3, b0, b1, ks);
      WT6(a0, a1, a2, a3, b0, b1);
      MM8(a0, a1, a2, a3, b0, b1);
    }
  }
#undef RD6
#undef AGP
#undef BGP
#undef WT6
#undef MM8
}

DI void phase0(const Params& P, char* smem) {
  char* ws = launder(P.ws);
  const int tid = launder_tid(), nb = gridDim.x, bid = blockIdx.x;
  float* tl = (float*)smem;
  for (int tile = bid; tile < 3136; tile += nb) {
    const float* W;
    int ld, K, srcbase = 0, ntn = 16, t;
    u16* dst;
    bool rot = false;
    if (tile < 1152) { t = tile; W = P.w_in; ld = 6664; K = 1024; ntn = 72; dst = (u16*)(ws + O_WIN); rot = true; }
    else if (tile < 1408) { t = tile - 1152; W = P.w_in; ld = 6664; K = 1024; srcbase = 5640; dst = (u16*)(ws + O_WGF); }
    else if (tile < 1664) { t = tile - 1408; W = P.w_in; ld = 6664; K = 1024; srcbase = 4616; dst = (u16*)(ws + O_WGR); }
    else if (tile < 1920) { t = tile - 1664; W = P.w_ret_o; ld = 1024; K = 1024; dst = (u16*)(ws + O_WRO); }
    else if (tile < 2048) { t = tile - 1920; W = P.w_fox_o; ld = 1024; K = 512; dst = (u16*)(ws + O_WFO); }
    else if (tile < 2304) { t = tile - 2048; W = P.w_out; ld = 1024; K = 1024; dst = (u16*)(ws + O_WO); }
    else if (tile < 2816) { t = tile - 2304; W = P.w_peer_q; ld = 2048; K = 1024; ntn = 32; dst = (u16*)(ws + O_WQ); }
    else if (tile < 3072) { t = tile - 2816; W = P.w_ple_gate; ld = 1024; K = 1024; dst = (u16*)(ws + O_WG); }
    else { t = tile - 3072; W = P.w_ple; ld = 1024; K = 256; dst = (u16*)(ws + O_WPLE); }
    const int n0 = (t % ntn) * 64, k0 = (t / ntn) * 64;
    {
      const int nn = tid & 63, kq = tid >> 6;
      const int n = n0 + nn;
      int src = n;
      if (rot && n < 1024) {
        const int np = n & 127;
        src = (n & ~127) + (((np >> 6) << 5) | (np & 31)) + 64 * ((np >> 5) & 1);
      }
      src += srcbase;
#pragma unroll
      for (int i = 0; i < 8; ++i) {
        const int kk = kq + 8 * i;
        tl[kk * 65 + nn] = W[(size_t)(k0 + kk) * ld + src];
      }
    }
    __syncthreads();
    {
      const int kk = tid & 63, nq = tid >> 6;
#pragma unroll
      for (int i = 0; i < 8; ++i) {
        const int nn = nq + 8 * i;
        dst[(size_t)(n0 + nn) * K + k0 + kk] = f2bf(tl[kk * 65 + nn]);
      }
    }
    __syncthreads();
  }
  const int gt = bid * NTHR + tid, nt = nb * NTHR;
  for (int i = gt; i < 4194304; i += nt) {
    const int e = i >> 8, k4 = (i & 255) * 4;
    const size_t di = ((size_t)(k4 >> 7) * 2097152 + (size_t)e * 128 + (k4 & 127)) >> 2;
    float4 a = ((const float4*)P.peer_u)[i];
    ((unsigned*)(ws + O_U))[di] = pack_fp8x4(a.x * U_SCALE, a.y * U_SCALE, a.z * U_SCALE, a.w * U_SCALE);
    a = ((const float4*)P.peer_v)[i];
    ((unsigned*)(ws + O_V))[di] = pack_fp8x4(a.x * V_SCALE, a.y * V_SCALE, a.z * V_SCALE, a.w * V_SCALE);
    a = ((const float4*)P.p)[i];
    u32x2 r = {pack2(a.x, a.y), pack2(a.z, a.w)};
    ((u32x2*)(ws + O_PB))[i] = r;
  }
  for (int i = gt; i < 65536; i += nt) {
    float4 a = ((const float4*)P.sub_keys)[i];
    u32x2 r = {pack2(a.x, a.y), pack2(a.z, a.w)};
    ((u32x2*)(ws + O_KEYS))[i] = r;
  }
  for (int i = gt; i < 131072; i += nt) {
    const int s = i >> 6, f = i & 63;
    const float inv = exp2f(-(float)f * 0.20762050593046f);
    const float angf = (float)s * inv;
    const double a = (double)angf;
    const double n = __builtin_rint(a * 0.15915494309189535);
    const float r = (float)(a - n * 6.283185307179586);
    float2 cs;
    cs.x = __cosf(r);
    cs.y = __sinf(r);
    ((float2*)(ws + O_ROPE))[i] = cs;
  }
  if (gt == 0) *(int*)(ws + O_CTR) = 0;
}

DI void ln_emb_rows(const Params& P, char* smem, int row0) {
  char* ws = launder(P.ws);
  const int tid = launder_tid(), lane = tid & 63, w = tid >> 6;
  float* wffT = (float*)(smem + L_WFF);
  __syncthreads();
  for (int idx = tid; idx < 8192; idx += NTHR) {
    const int k = idx >> 3, j = idx & 7;
    wffT[j * 1024 + k] = P.w_in[(size_t)k * 6664 + 4608 + j];
  }
  __syncthreads();
  u16* h0 = (u16*)(ws + O_H0);
  float* logf_ = (float*)(ws + O_LOGF);
  float4 nx[4];
#pragma unroll
  for (int q = 0; q < 4; ++q) nx[q] = *(const float4*)(P.x + (size_t)(row0 + w * 32) * 1024 + q * 256 + lane * 4);
  for (int i = 0; i < 32; ++i) {
    const int t = row0 + w * 32 + i;
    float v[16];
    float sum = 0.f;
    float4 cx[4];
#pragma unroll
    for (int q = 0; q < 4; ++q) cx[q] = nx[q];
    if (i + 1 < 32) {
#pragma unroll
      for (int q = 0; q < 4; ++q) nx[q] = *(const float4*)(P.x + (size_t)(t + 1) * 1024 + q * 256 + lane * 4);
    }
#pragma unroll
    for (int q = 0; q < 4; ++q) {
      float4 a = cx[q];
      v[4 * q] = a.x; v[4 * q + 1] = a.y; v[4 * q + 2] = a.z; v[4 * q + 3] = a.w;
      sum += a.x + a.y + a.z + a.w;
    }
    const float mean = wave_sum(sum) * (1.f / 1024.f);
    float sq = 0.f;
#pragma unroll
    for (int e = 0; e < 16; ++e) { v[e] -= mean; sq += v[e] * v[e]; }
    const float rstd = rsqrtf(wave_sum(sq) * (1.f / 1024.f) + LN_EPS);
    float ff[8];
#pragma unroll
    for (int j = 0; j < 8; ++j) ff[j] = 0.f;
#pragma unroll
    for (int q = 0; q < 4; ++q) {
      const int c = q * 256 + lane * 4;
      float4 g = *(const float4*)(P.ln_emb_g + c);
      float4 bb = *(const float4*)(P.ln_emb_b + c);
      const float y0 = v[4 * q] * rstd * g.x + bb.x, y1 = v[4 * q + 1] * rstd * g.y + bb.y,
                  y2 = v[4 * q + 2] * rstd * g.z + bb.z, y3 = v[4 * q + 3] * rstd * g.w + bb.w;
      u32x2 r = {pack2(y0, y1), pack2(y2, y3)};
      *(u32x2*)(h0 + (size_t)t * 1024 + c) = r;
#pragma unroll
      for (int j = 0; j < 8; ++j) {
        float4 wv = *(const float4*)(wffT + j * 1024 + c);
        ff[j] += y0 * wv.x + y1 * wv.y + y2 * wv.z + y3 * wv.w;
      }
    }
    float mine = 0.f;
#pragma unroll
    for (int j = 0; j < 8; ++j) {
      const float s = wave_sum(ff[j]);
      mine = (lane == j) ? s : mine;
    }
    if (lane < 8) {
      const float z = mine + P.b_forget[lane];
      const float lf = fminf(z, 0.f) - log1pf(__expf(-fabsf(z)));
      const int b = t >> 11, s = t & 2047;
      logf_[(size_t)(b * 8 + lane) * 2048 + s] = lf;
    }
  }
}

DI void p1_epilogue(const Params& P, int T, int row0, char* smem, f32x16 (&acc)[8]) {
  char* ws = launder(P.ws);
  const int tid_ = launder_tid();
  const int lane = tid_ & 63, w = tid_ >> 6, wr = w >> 2, wc4 = w & 3, sub = wc4 >> 1, wc = wc4 & 1, h = lane >> 5, p = lane & 31;
  const int b = row0 >> 11, s0 = row0 & 2047;
  u16* T_ = (u16*)smem;
  __syncthreads();
  if (T < 4) {
    const float sc = T >= 2 ? 0.08838834764831845f : 1.f;
#pragma unroll
    for (int mb = 0; mb < 4; ++mb) {
      const int r = wr * 128 + mb * 32 + p;
      const float* rp = (const float*)(ws + O_ROPE) + (size_t)((s0 + r) * 64 + wc * 32 + 4 * h) * 2;
      u16* d = T_ + r * LDQ2 + sub * 128 + wc * 64 + 4 * h;
#pragma unroll
      for (int g = 0; g < 4; ++g) {
        const float4 c01 = *(const float4*)(rp + 16 * g);
        const float4 c23 = *(const float4*)(rp + 16 * g + 4);
        const float cs[4] = {c01.x, c01.z, c23.x, c23.z};
        const float sn[4] = {c01.y, c01.w, c23.y, c23.w};
        float o1[4], o2[4];
#pragma unroll
        for (int ii = 0; ii < 4; ++ii) {
          const float x1 = AS(0, mb)[4 * g + ii], x2 = AS(1, mb)[4 * g + ii];
          o1[ii] = (x1 * cs[ii] - x2 * sn[ii]) * sc;
          o2[ii] = (x2 * cs[ii] + x1 * sn[ii]) * sc;
        }
        u32x2 r1 = {pack2(o1[0], o1[1]), pack2(o1[2], o1[3])};
        u32x2 r2 = {pack2(o2[0], o2[1]), pack2(o2[2], o2[3])};
        *(u32x2*)(d + 8 * g) = r1;
        *(u32x2*)(d + 8 * g + 32) = r2;
      }
    }
  } else if (T < 6) {
    const int hd = 2 * (T - 4) + sub;
    const float lg = logf(1.f - exp2f(-5.f - (float)hd));
    const int f = wc * 32 + p;
#pragma unroll
    for (int mb = 0; mb < 4; ++mb) {
      const int rb0 = wr * 128 + mb * 32 + 4 * h;
      const float2* rp = (const float2*)(ws + O_ROPE) + (size_t)(s0 + rb0) * 64 + f;
      u16* d = T_ + (sub * 128 + wc * 64 + p) * LDQ2 + rb0;
#pragma unroll
      for (int g = 0; g < 4; ++g) {
        float o1[4], o2[4];
#pragma unroll
        for (int ii = 0; ii < 4; ++ii) {
          const float2 cs = rp[(8 * g + ii) * 64];
          const float x1 = AN(mb, 0)[4 * g + ii], x2 = AN(mb, 1)[4 * g + ii];
          const int s = s0 + rb0 + 8 * g + ii;
          const float kd = __expf(lg * (float)(127 - (s & 127))) * 0.08838834764831845f;
          o1[ii] = (x1 * cs.x - x2 * cs.y) * kd;
          o2[ii] = (x2 * cs.x + x1 * cs.y) * kd;
        }
        u32x2 r1 = {pack2(o1[0], o1[1]), pack2(o1[2], o1[3])};
        u32x2 r2 = {pack2(o2[0], o2[1]), pack2(o2[2], o2[3])};
        *(u32x2*)(d + 8 * g) = r1;
        *(u32x2*)(d + 32 * LDQ2 + 8 * g) = r2;
      }
    }
  } else if (T < 10 || T >= 18) {
#pragma unroll
    for (int mb = 0; mb < 4; ++mb)
#pragma unroll
      for (int nb = 0; nb < 2; ++nb)
#pragma unroll
        for (int g = 0; g < 4; ++g) {
          u32x2 r = {pack2(AN(mb, nb)[4 * g], AN(mb, nb)[4 * g + 1]), pack2(AN(mb, nb)[4 * g + 2], AN(mb, nb)[4 * g + 3])};
          *(u32x2*)(T_ + (wc4 * 64 + nb * 32 + p) * LDQ2 + wr * 128 + mb * 32 + 8 * g + 4 * h) = r;
        }
  } else {
    const int mode = T < 14 ? 0 : T < 16 ? 1 : 2;
#pragma unroll
    for (int mb = 0; mb < 4; ++mb)
#pragma unroll
      for (int nb = 0; nb < 2; ++nb)
#pragma unroll
        for (int g = 0; g < 4; ++g) {
          float x[4];
#pragma unroll
          for (int ii = 0; ii < 4; ++ii) {
            x[ii] = AS(nb, mb)[4 * g + ii];
            if (mode == 0) x[ii] = x[ii] * sigmoidf_(x[ii]);
            else if (mode == 1) x[ii] *= 0.125f;
          }
          u32x2 r = {pack2(x[0], x[1]), pack2(x[2], x[3])};
          *(u32x2*)(T_ + (wr * 128 + mb * 32 + p) * LDQ2 + wc4 * 64 + nb * 32 + 8 * g + 4 * h) = r;
        }
  }
  __syncthreads();
  u16* dst;
  size_t rstride;
  if (T < 2) { dst = (u16*)(ws + O_QR) + (size_t)row0 * 512 + T * 256; rstride = 512; }
  else if (T < 4) { dst = (u16*)(ws + O_KR) + (size_t)row0 * 512 + (T - 2) * 256; rstride = 512; }
  else if (T < 6) { dst = (u16*)(ws + O_KTD) + (size_t)((b * 4 + 2 * (T - 4)) * 128) * 2048 + s0; rstride = 2048; }
  else if (T < 10) { dst = (u16*)(ws + O_VT) + (size_t)((b * 4 + (T - 6)) * 256) * 2048 + s0; rstride = 2048; }
  else if (T < 14) { dst = (u16*)(ws + O_RG) + (size_t)row0 * 1024 + (T - 10) * 256; rstride = 1024; }
  else if (T < 16) { dst = (u16*)(ws + O_FQ) + (size_t)row0 * 512 + (T - 14) * 256; rstride = 512; }
  else if (T < 18) { dst = (u16*)(ws + O_FK) + (size_t)row0 * 512 + (T - 16) * 256; rstride = 512; }
  else { dst = (u16*)(ws + O_FVT) + (size_t)((b * 8 + (T - 18) * 4) * 64) * 2048 + s0; rstride = 2048; }
#pragma unroll 4
  for (int i = 0; i < 16; ++i) {
    const int id = tid_ + NTHR * i, r = id >> 5, kc = id & 31;
    *(u32x4*)(dst + (size_t)r * rstride + kc * 8) = *(const u32x4*)(T_ + r * LDQ2 + kc * 8);
  }
}

DI void retention_item(const Params& P, char* smem, int item) {
  char* ws = launder(P.ws);
  const int tid = launder_tid(), lane = tid & 63, w = tid >> 6, h = lane >> 5, p = lane & 31;
  const int b = item >> 2, hd = item & 3;
  u16* Qs = (u16*)smem;
  u16* Ps = (u16*)(smem + 34816);
  u16* Ks = (u16*)(smem + 69632);
  u16* KTs = (u16*)(smem + 104448);
  float* stats = (float*)(smem + 139264);
  float* mr = (float*)(smem + 147456);
  const u16* qr = (const u16*)(ws + O_QR);
  const u16* kr = (const u16*)(ws + O_KR);
  const u16* vt = (const u16*)(ws + O_VT) + (size_t)((b * 4 + hd) * 256 + w * 32 + p) * 2048 + 8 * h;
  const u16* ktd = (const u16*)(ws + O_KTD) + (size_t)((b * 4 + hd) * 128) * 2048;
  u16* rg = (u16*)(ws + O_RG);
  const float lg = logf(1.f - exp2f(-5.f - (float)hd));
  const float cd = __expf(lg * 128.f);
  f32x16 R[4], OT[4];
#pragma unroll
  for (int a = 0; a < 4; ++a)
#pragma unroll
    for (int i = 0; i < 16; ++i) R[a][i] = 0.f;
  const float lg0 = lg;
  for (int c = 0; c < 16; ++c) {
    const int t0 = b * 2048 + c * 128;
    float lg = lg0;
    asm volatile("" : "+v"(lg));
    __syncthreads();
    {
      u32x4 tq[4], tk[4], tt2[4];
#pragma unroll
      for (int i = 0; i < 4; ++i) {
        const int id = tid + NTHR * i, row = id >> 4, kc = id & 15;
        tq[i] = *(const u32x4*)(qr + (size_t)(t0 + row) * 512 + hd * 128 + kc * 8);
        tk[i] = *(const u32x4*)(kr + (size_t)(t0 + row) * 512 + hd * 128 + kc * 8);
        tt2[i] = *(const u32x4*)(ktd + (size_t)row * 2048 + c * 128 + kc * 8);
      }
#pragma unroll
      for (int i = 0; i < 4; ++i) {
        const int id = tid + NTHR * i, row = id >> 4, kc = id & 15;
        *(u32x4*)(Qs + row * LDQ + kc * 8) = tq[i];
        *(u32x4*)(Ks + row * LDQ + kc * 8) = tk[i];
        *(u32x4*)(KTs + row * LDQ + kc * 8) = tt2[i];
      }
    }
    __syncthreads();
#pragma unroll
    for (int tt = 0; tt < 2; ++tt) {
      const int id = w + 8 * tt, ib = id >> 2, jb = id & 3;
      f32x16 st;
#pragma unroll
      for (int i = 0; i < 16; ++i) st[i] = 0.f;
      if (jb <= ib) {
        const u16* kp = Ks + (jb * 32 + p) * LDQ + 8 * h;
        const u16* qp = Qs + (ib * 32 + p) * LDQ + 8 * h;
#pragma unroll 4
        for (int s = 0; s < 8; ++s) st = MFMA32(ld8(kp + 16 * s), ld8(qp + 16 * s), st);
      }
      const int iq = ib * 32 + p;
#pragma unroll
      for (int g = 0; g < 4; ++g) {
        float v4[4];
#pragma unroll
        for (int ii = 0; ii < 4; ++ii) {
          const int df = iq - (jb * 32 + 8 * g + 4 * h + ii);
          v4[ii] = (df >= 0) ? st[4 * g + ii] * __expf(lg * (float)df) : 0.f;
        }
        u32x2 r = {pack2(v4[0], v4[1]), pack2(v4[2], v4[3])};
        *(u32x2*)(Ps + iq * LDQ + jb * 32 + 8 * g + 4 * h) = r;
      }
    }
    __syncthreads();
#pragma unroll
    for (int a = 0; a < 4; ++a)
#pragma unroll
      for (int i = 0; i < 16; ++i) OT[a][i] = 0.f;
    {
#pragma unroll
      for (int db = 0; db < 4; ++db)
#pragma unroll
        for (int s = 0; s < 2; ++s) {
          const bf16x8 ra = pack8(R[db], s);
#pragma unroll
          for (int ib = 0; ib < 4; ++ib) {
            const u16* qp = Qs + (ib * 32 + p) * LDQ + 32 * db + 16 * s + 4 * h;
            OT[ib] = MFMA32(ra, join44(*(const u32x2*)qp, *(const u32x2*)(qp + 8)), OT[ib]);
          }
          __builtin_amdgcn_sched_barrier(0);
        }
#pragma unroll
      for (int ib = 0; ib < 4; ++ib) {
        const float qd = __expf(lg * (float)(ib * 32 + p + 1));
#pragma unroll
        for (int i = 0; i < 16; ++i) OT[ib][i] *= qd;
      }
    }
#pragma unroll
    for (int db = 0; db < 4; ++db)
#pragma unroll
      for (int i = 0; i < 16; ++i) R[db][i] *= cd;
    bf16x8 vf = ld8(vt + c * 128);
#pragma unroll 1
    for (int s = 0; s < 8; ++s) {
      bf16x8 vfn = vf;
      if (s < 7) vfn = ld8(vt + c * 128 + 16 * (s + 1));
#pragma unroll
      for (int ib = 0; ib < 4; ++ib)
        if (s <= 2 * ib + 1) OT[ib] = MFMA32(vf, ld8(Ps + (ib * 32 + p) * LDQ + 16 * s + 8 * h), OT[ib]);
#pragma unroll
      for (int db = 0; db < 4; ++db) R[db] = MFMA32(ld8(KTs + (db * 32 + p) * LDQ + 16 * s + 8 * h), vf, R[db]);
      vf = vfn;
    }
#pragma unroll
    for (int ib = 0; ib < 4; ++ib) {
      float s1 = 0.f, s2 = 0.f;
#pragma unroll
      for (int i = 0; i < 16; ++i) { s1 += OT[ib][i]; s2 += OT[ib][i] * OT[ib][i]; }
      s1 += __shfl_xor(s1, 32);
      s2 += __shfl_xor(s2, 32);
      if (h == 0) {
        stats[(w * 128 + ib * 32 + p) * 2] = s1;
        stats[(w * 128 + ib * 32 + p) * 2 + 1] = s2;
      }
    }
    __syncthreads();
    if (tid < 128) {
      float s1 = 0.f, s2 = 0.f;
#pragma unroll
      for (int ww = 0; ww < 8; ++ww) { s1 += stats[(ww * 128 + tid) * 2]; s2 += stats[(ww * 128 + tid) * 2 + 1]; }
      const float mean = s1 * (1.f / 256.f);
      const float var = fmaxf(s2 * (1.f / 256.f) - mean * mean, 0.f);
      mr[tid * 2] = mean;
      mr[tid * 2 + 1] = rsqrtf(var + LN_EPS);
    }
    __syncthreads();
    {
      u16* Ys = (u16*)smem;
#pragma unroll
      for (int ib = 0; ib < 4; ++ib) {
        const float mean = mr[(ib * 32 + p) * 2], rstd = mr[(ib * 32 + p) * 2 + 1];
        u16* yp = Ys + (ib * 32 + p) * LDQ2 + w * 32 + 4 * h;
#pragma unroll
        for (int g = 0; g < 4; ++g) {
          u32x2 r = {pack2((OT[ib][4 * g] - mean) * rstd, (OT[ib][4 * g + 1] - mean) * rstd),
                     pack2((OT[ib][4 * g + 2] - mean) * rstd, (OT[ib][4 * g + 3] - mean) * rstd)};
          *(u32x2*)(yp + 8 * g) = r;
        }
      }
      __syncthreads();
#pragma unroll 2
      for (int i = 0; i < 8; ++i) {
        const int id = tid + NTHR * i, row = id >> 5, kc = id & 31;
        u16* gp = rg + (size_t)(t0 + row) * 1024 + hd * 256 + kc * 8;
        const u32x4 sg = *(const u32x4*)gp;
        const u32x4 yv = *(const u32x4*)(Ys + row * LDQ2 + kc * 8);
        u32x4 o;
#pragma unroll
        for (int q = 0; q < 4; ++q)
          o[q] = pack2(__uint_as_float(yv[q] << 16) * __uint_as_float(sg[q] << 16),
                       __uint_as_float(yv[q] & 0xffff0000u) * __uint_as_float(sg[q] & 0xffff0000u));
        *(u32x4*)gp = o;
      }
    }
  }
}

DI void attention_item(const Params& P, char* smem, int item) {
  char* ws = launder(P.ws);
  const int tid = launder_tid(), lane = tid & 63, w = tid >> 6, h = lane >> 5, p = lane & 31;
  const int qb = 7 - (item >> 8), bh = item & 255, b = bh >> 3, h8 = bh & 7;
  float* cl = (float*)smem;
  u16* Ks = (u16*)(smem + 8192);
  u16* Vs = (u16*)(smem + 17408);
  float* wsum = (float*)(smem + 26624);
  const float* logf_ = (const float*)(ws + O_LOGF) + (size_t)bh * 2048;
  __syncthreads();
  {
    float4 a = *(const float4*)(logf_ + tid * 4);
    a.y += a.x; a.z += a.y; a.w += a.z;
    float tot = a.w;
#pragma unroll
    for (int o = 1; o < 64; o <<= 1) {
      const float n = __shfl_up(tot, o);
      if (lane >= o) tot += n;
    }
    if (lane == 63) wsum[w] = tot;
    __syncthreads();
    float off = tot - a.w;
#pragma unroll
    for (int ww = 0; ww < 8; ++ww) off += (ww < w) ? wsum[ww] : 0.f;
    a.x += off; a.y += off; a.z += off; a.w += off;
    *(float4*)(cl + tid * 4) = a;
  }
  __syncthreads();
  u16* fq = (u16*)(ws + O_FQ);
  const u16* fk = (const u16*)(ws + O_FK);
  const u16* fvt = (const u16*)(ws + O_FVT) + (size_t)(bh * 64) * 2048;
  const int qs = qb * 256 + w * 32 + p;
  const size_t qrow = (size_t)(b * 2048 + qs) * 512 + h8 * 64;
  bf16x8 qf[4];
#pragma unroll
  for (int s = 0; s < 4; ++s) qf[s] = ld8(fq + qrow + 16 * s + 8 * h);
  const float cq = cl[qs];
  f32x16 OT[2];
#pragma unroll
  for (int a = 0; a < 2; ++a)
#pragma unroll
    for (int i = 0; i < 16; ++i) OT[a][i] = 0.f;
  float m = -1e30f, l = 0.f;
  const int nkt = 4 * (qb + 1);
  const int wave_qmax = qb * 256 + w * 32 + 31;
  const int sr = tid >> 3, skc = tid & 7;
  const u16* kgp = fk + (size_t)(b * 2048 + sr) * 512 + h8 * 64 + skc * 8;
  const u16* vgp = fvt + (size_t)sr * 2048 + skc * 8;
  u32x4 kreg = *(const u32x4*)kgp;
  u32x4 vreg = *(const u32x4*)vgp;
  for (int kt = 0; kt < nkt; ++kt) {
    __syncthreads();
    *(u32x4*)(Ks + sr * LDK + skc * 8) = kreg;
    *(u32x4*)(Vs + sr * LDK + skc * 8) = vreg;
    __syncthreads();
    if (kt + 1 < nkt) {
      kreg = *(const u32x4*)(kgp + (size_t)(kt + 1) * 64 * 512);
      vreg = *(const u32x4*)(vgp + (kt + 1) * 64);
    }
    if (kt * 64 <= wave_qmax) {
      f32x16 st[2];
#pragma unroll
      for (int kb = 0; kb < 2; ++kb) {
#pragma unroll
        for (int i = 0; i < 16; ++i) st[kb][i] = 0.f;
#pragma unroll
        for (int s = 0; s < 4; ++s) {
          bf16x8 a = ld8(Ks + (kb * 32 + p) * LDK + 16 * s + 8 * h);
          st[kb] = MFMA32(a, qf[s], st[kb]);
        }
      }
      float mx = -1e30f;
#pragma unroll
      for (int kb = 0; kb < 2; ++kb)
#pragma unroll
        for (int g = 0; g < 4; ++g) {
          const int kbase = kt * 64 + kb * 32 + 8 * g + 4 * h;
          const float4 ck = *(const float4*)(cl + kbase);
          const float cks[4] = {ck.x, ck.y, ck.z, ck.w};
#pragma unroll
          for (int ii = 0; ii < 4; ++ii) {
            float v = st[kb][4 * g + ii] + cq - cks[ii];
            v = (kbase + ii <= qs) ? v : -1e30f;
            st[kb][4 * g + ii] = v;
            mx = fmaxf(mx, v);
          }
        }
      mx = fmaxf(mx, __shfl_xor(mx, 32));
      const float mn = fmaxf(m, mx);
      const float alpha = __expf(m - mn);
      m = mn;
      float ps = 0.f;
#pragma unroll
      for (int kb = 0; kb < 2; ++kb)
#pragma unroll
        for (int i = 0; i < 16; ++i) {
          const float e = __expf(st[kb][i] - mn);
          st[kb][i] = e;
          ps += e;
        }
      l = l * alpha + ps;
#pragma unroll
      for (int a = 0; a < 2; ++a)
#pragma unroll
        for (int i = 0; i < 16; ++i) OT[a][i] *= alpha;
#pragma unroll
      for (int kb = 0; kb < 2; ++kb)
#pragma unroll
        for (int s = 0; s < 2; ++s) {
          const bf16x8 pf = pack8(st[kb], s);
#pragma unroll
          for (int db = 0; db < 2; ++db) {
            const u16* vp = Vs + (db * 32 + p) * LDK + kb * 32 + 16 * s + 4 * h;
            bf16x8 a = join44(*(const u32x2*)vp, *(const u32x2*)(vp + 8));
            OT[db] = MFMA32(a, pf, OT[db]);
          }
        }
    }
  }
  l += __shfl_xor(l, 32);
  const float il = 1.f / l;
#pragma unroll
  for (int db = 0; db < 2; ++db)
#pragma unroll
    for (int g = 0; g < 4; ++g) {
      u32x2 r = {pack2(OT[db][4 * g] * il, OT[db][4 * g + 1] * il), pack2(OT[db][4 * g + 2] * il, OT[db][4 * g + 3] * il)};
      *(u32x2*)((u16*)(ws + O_YF) + qrow + db * 32 + 8 * g + 4 * h) = r;
    }
}

DI unsigned okey(float f) {
  const unsigned u = __float_as_uint(f);
  return u ^ ((unsigned)((int)u >> 31) | 0x80000000u);
}
DI float okey_inv(unsigned k) {
  const unsigned u = (k & 0x80000000u) ? (k ^ 0x80000000u) : ~k;
  return __uint_as_float(u);
}
DI void ce_desc(unsigned& a, unsigned& b) {
  const unsigned hi = max(a, b), lo = min(a, b);
  a = hi;
  b = lo;
}
DI void sort16_desc(unsigned (&a)[16]) {
#pragma unroll
  for (int k = 2; k <= 16; k <<= 1)
#pragma unroll
    for (int j = k >> 1; j > 0; j >>= 1)
#pragma unroll
      for (int i = 0; i < 16; ++i) {
        const int l = i ^ j;
        if (l > i) {
          if ((i & k) == 0) ce_desc(a[i], a[l]);
          else ce_desc(a[l], a[i]);
        }
      }
}
DI void merge_top16(unsigned (&L)[16], const unsigned (&N)[16]) {
#pragma unroll
  for (int i = 0; i < 16; ++i) L[i] = max(L[i], N[15 - i]);
#pragma unroll
  for (int j = 8; j > 0; j >>= 1)
#pragma unroll
    for (int i = 0; i < 16; ++i) {
      const int l = i ^ j;
      if (l > i) ce_desc(L[i], L[l]);
    }
}
DI void ins16(unsigned (&L)[16], unsigned x) {
#pragma unroll
  for (int i = 0; i < 16; ++i) {
    const unsigned hi = max(L[i], x);
    x = min(L[i], x);
    L[i] = hi;
  }
}

#define STAGE_SW(NT, ...)                                                               \
  {                                                                                     \
    __syncthreads();                                                                    \
    const int t_ = launder_tid(), l_ = t_ & 63, w_ = t_ >> 6;                           \
    const int wr = w_ >> 2, wc = w_ & 3, h = l_ >> 5, p = l_ & 31;                      \
    u16* T_ = (u16*)smem;                                                               \
    _Pragma("unroll") for (int mb = 0; mb < 4; ++mb) {                                  \
      const int r_ = wr * 128 + mb * 32 + p;                                            \
      _Pragma("unroll") for (int nb = 0; nb < 2; ++nb) _Pragma("unroll") for (int g = 0; g < 4; ++g) { \
        const int cl_ = wc * 64 + nb * 32 + 8 * g + 4 * h;                              \
        const int c_ = (NT) * 256 + cl_;                                                \
        float v0 = AS(nb, mb)[4 * g], v1 = AS(nb, mb)[4 * g + 1], v2 = AS(nb, mb)[4 * g + 2], v3 = AS(nb, mb)[4 * g + 3]; \
        (void)c_;                                                                       \
        __VA_ARGS__                                                                     \
        u32x2 pk_ = {pack2(v0, v1), pack2(v2, v3)};                                     \
        *(u32x2*)(T_ + r_ * LDQ2 + cl_) = pk_;                                          \
      }                                                                                 \
    }                                                                                   \
    __syncthreads();                                                                    \
  }
#define ROWS_SW(NT, ...)                                                                \
  {                                                                                     \
    const int t_ = launder_tid();                                                       \
    const u16* T_ = (const u16*)smem;                                                   \
    _Pragma("unroll 4") for (int i_ = 0; i_ < 16; ++i_) {                               \
      const int id_ = t_ + NTHR * i_, r_ = id_ >> 5, kc_ = id_ & 31;                    \
      const int c_ = (NT) * 256 + kc_ * 8;                                              \
      const u32x4 t = *(const u32x4*)(T_ + r_ * LDQ2 + kc_ * 8);                        \
      __VA_ARGS__                                                                       \
    }                                                                                   \
  }
#define BFLO(x) __uint_as_float((x) << 16)
#define BFHI(x) __uint_as_float((x) & 0xffff0000u)
DI void chain_gemms(const Params& P, char* smem, int row0) {
  char* ws = launder(P.ws);
  const u16* h0 = (const u16*)(ws + O_H0) + (size_t)row0 * 1024;
  const u16* yf = (const u16*)(ws + O_YF) + (size_t)row0 * 512;
  const u16* ar = (const u16*)(ws + O_RG) + (size_t)row0 * 1024;
  u16* merged = (u16*)(ws + O_MERGED) + (size_t)row0 * 1024;
  float* pre1 = (float*)(ws + O_PRE1) + (size_t)row0 * 1024;
  u16* gsc = (u16*)pre1;
  f32x16 acc[8];
  for (int nt = 0; nt < 4; ++nt) {
    zero_acc8(acc);
    gemm_loop<true>(h0, 1024, (const u16*)(ws + O_WGF) + (size_t)nt * 256 * 1024, 1024, 1024, smem, acc);
    STAGE_SW(nt, {
      const float4 bb = *(const float4*)(P.b_bg + 1024 + c_);
      v0 = sigmoidf_(v0 + bb.x); v1 = sigmoidf_(v1 + bb.y); v2 = sigmoidf_(v2 + bb.z); v3 = sigmoidf_(v3 + bb.w);
    })
    ROWS_SW(nt, { *(u32x4*)(merged + (size_t)r_ * 1024 + c_) = t; })
  }
  for (int nt = 0; nt < 4; ++nt) {
    zero_acc8(acc);
    gemm_loop<true>(yf, 512, (const u16*)(ws + O_WFO) + (size_t)nt * 256 * 512, 512, 512, smem, acc);
    STAGE_SW(nt, {})
    ROWS_SW(nt, {
      u32x4* mp = (u32x4*)(merged + (size_t)r_ * 1024 + c_);
      const u32x4 m = *mp;
      u32x4 o;
      _Pragma("unroll") for (int q = 0; q < 4; ++q) o[q] = pack2(BFLO(m[q]) * BFLO(t[q]), BFHI(m[q]) * BFHI(t[q]));
      *mp = o;
    })
  }
  for (int nt = 0; nt < 4; ++nt) {
    zero_acc8(acc);
    gemm_loop<true>(h0, 1024, (const u16*)(ws + O_WGR) + (size_t)nt * 256 * 1024, 1024, 1024, smem, acc);
    STAGE_SW(nt, {
      const float4 bb = *(const float4*)(P.b_bg + c_);
      v0 = sigmoidf_(v0 + bb.x); v1 = sigmoidf_(v1 + bb.y); v2 = sigmoidf_(v2 + bb.z); v3 = sigmoidf_(v3 + bb.w);
    })
    ROWS_SW(nt, { *(u32x4*)(gsc + (size_t)r_ * 1024 + c_) = t; })
  }
  for (int nt = 0; nt < 4; ++nt) {
    zero_acc8(acc);
    gemm_loop<true>(ar, 1024, (const u16*)(ws + O_WRO) + (size_t)nt * 256 * 1024, 1024, 1024, smem, acc);
    STAGE_SW(nt, {})
    ROWS_SW(nt, {
      u32x4* mp = (u32x4*)(merged + (size_t)r_ * 1024 + c_);
      const u32x4 m = *mp;
      const u32x4 gq = *(const u32x4*)(gsc + (size_t)r_ * 1024 + c_);
      u32x4 o;
      _Pragma("unroll") for (int q = 0; q < 4; ++q)
        o[q] = pack2(BFLO(m[q]) + BFLO(gq[q]) * BFLO(t[q]), BFHI(m[q]) + BFHI(gq[q]) * BFHI(t[q]));
      *mp = o;
    })
  }
  __syncthreads();
  for (int nt = 0; nt < 4; ++nt) {
    zero_acc8(acc);
    gemm_loop<true>(merged, 1024, (const u16*)(ws + O_WO) + (size_t)nt * 256 * 1024, 1024, 1024, smem, acc);
    STAGE_SW(nt, {})
    ROWS_SW(nt, {
      const u32x4 hh = *(const u32x4*)(h0 + (size_t)r_ * 1024 + c_);
      float4 y0; float4 y1;
      y0.x = ALPHA * BFLO(hh[0]) + BFLO(t[0]); y0.y = ALPHA * BFHI(hh[0]) + BFHI(t[0]);
      y0.z = ALPHA * BFLO(hh[1]) + BFLO(t[1]); y0.w = ALPHA * BFHI(hh[1]) + BFHI(t[1]);
      y1.x = ALPHA * BFLO(hh[2]) + BFLO(t[2]); y1.y = ALPHA * BFHI(hh[2]) + BFHI(t[2]);
      y1.z = ALPHA * BFLO(hh[3]) + BFLO(t[3]); y1.w = ALPHA * BFHI(hh[3]) + BFHI(t[3]);
      float* pp = pre1 + (size_t)r_ * 1024 + c_;
      *(float4*)pp = y0;
      *(float4*)(pp + 4) = y1;
    })
  }
}

DI void chain_ln1(const Params& P, char* smem, int row0) {
  char* ws = launder(P.ws);
  const int tid = launder_tid(), lane = tid & 63, w = tid >> 6, wr = w >> 1, wc = w & 1, h = lane >> 5, p = lane & 31;
  (void)wr; (void)wc; (void)h; (void)p; (void)lane; (void)w;
  float* pre1 = (float*)(ws + O_PRE1) + (size_t)row0 * 1024;
  u16* h1b = (u16*)(ws + O_H1B) + (size_t)row0 * 1024;
  unsigned char* x8 = (unsigned char*)(ws + O_X8) + (size_t)row0 * 1024;
  float4 nx[4];
#pragma unroll
  for (int q = 0; q < 4; ++q) nx[q] = *(const float4*)(pre1 + (size_t)(w * 32) * 1024 + q * 256 + lane * 4);
  for (int i = 0; i < 32; ++i) {
    const int r = w * 32 + i;
    float v[16];
    float sum = 0.f;
    float4 cx[4];
#pragma unroll
    for (int q = 0; q < 4; ++q) cx[q] = nx[q];
    if (i + 1 < 32) {
#pragma unroll
      for (int q = 0; q < 4; ++q) nx[q] = *(const float4*)(pre1 + (size_t)(r + 1) * 1024 + q * 256 + lane * 4);
    }
#pragma unroll
    for (int q = 0; q < 4; ++q) {
      float4 a = cx[q];
      v[4 * q] = a.x; v[4 * q + 1] = a.y; v[4 * q + 2] = a.z; v[4 * q + 3] = a.w;
      sum += a.x + a.y + a.z + a.w;
    }
    const float mean = wave_sum(sum) * (1.f / 1024.f);
    float sq = 0.f;
#pragma unroll
    for (int e = 0; e < 16; ++e) { v[e] -= mean; sq += v[e] * v[e]; }
    const float rstd = rsqrtf(wave_sum(sq) * (1.f / 1024.f) + LN_EPS);
#pragma unroll
    for (int q = 0; q < 4; ++q) {
      const int c = q * 256 + lane * 4;
      float4 g = *(const float4*)(P.ln1_g + c);
      float4 bb = *(const float4*)(P.ln1_b + c);
      float4 y;
      y.x = v[4 * q] * rstd * g.x + bb.x; y.y = v[4 * q + 1] * rstd * g.y + bb.y;
      y.z = v[4 * q + 2] * rstd * g.z + bb.z; y.w = v[4 * q + 3] * rstd * g.w + bb.w;
      *(float4*)(pre1 + (size_t)r * 1024 + c) = y;
      u32x2 rr = {pack2(y.x, y.y), pack2(y.z, y.w)};
      *(u32x2*)(h1b + (size_t)r * 1024 + c) = rr;
      *(unsigned*)(x8 + (size_t)r * 1024 + c) = pack_fp8x4(y.x * X_SCALE, y.y * X_SCALE, y.z * X_SCALE, y.w * X_SCALE);
    }
  }
}

DI void chain_ple(const Params& P, char* smem, int row0) {
  char* ws = launder(P.ws);
  const u16* h1b = (const u16*)(ws + O_H1B) + (size_t)row0 * 1024;
  u16* ple = (u16*)(ws + O_PLE) + (size_t)row0 * 1024;
  const u16* pb = (const u16*)(ws + O_PB) + (size_t)row0 * 256;
  f32x16 acc[8];
  for (int nt = 0; nt < 4; ++nt) {
    zero_acc8(acc);
    gemm_loop<true>(h1b, 1024, (const u16*)(ws + O_WG) + (size_t)nt * 256 * 1024, 1024, 1024, smem, acc);
    STAGE_SW(nt, {
      const float4 bb = *(const float4*)(P.b_ple_gate + c_);
      v0 = sigmoidf_(v0 + bb.x); v1 = sigmoidf_(v1 + bb.y); v2 = sigmoidf_(v2 + bb.z); v3 = sigmoidf_(v3 + bb.w);
    })
    ROWS_SW(nt, { *(u32x4*)(ple + (size_t)r_ * 1024 + c_) = t; })
  }
  for (int nt = 0; nt < 4; ++nt) {
    zero_acc8(acc);
    gemm_loop<true>(pb, 256, (const u16*)(ws + O_WPLE) + (size_t)nt * 256 * 256, 256, 256, smem, acc);
    STAGE_SW(nt, {})
    ROWS_SW(nt, {
      u32x4* mp = (u32x4*)(ple + (size_t)r_ * 1024 + c_);
      const u32x4 m = *mp;
      u32x4 o;
      _Pragma("unroll") for (int q = 0; q < 4; ++q) o[q] = pack2(BFLO(m[q]) * BFLO(t[q]), BFHI(m[q]) * BFHI(t[q]));
      *mp = o;
    })
  }
}

DI void chain_topk(const Params& P, char* smem, int row0) {
  f32x16 acc[8];
  u16* Q2 = (u16*)smem;
  u16* Kt = (u16*)(smem + 135168);
  for (int hh = 0; hh < 8; ++hh) {
    zero_acc8(acc);
    {
      char* ws0 = launder(P.ws);
      gemm_loop<true>((const u16*)(ws0 + O_H1B) + (size_t)row0 * 1024, 1024, (const u16*)(ws0 + O_WQ) + (size_t)hh * 256 * 1024, 1024, 1024, smem, acc);
    }
    char* ws = launder(P.ws);
    const int tid = launder_tid(), lane = tid & 63, w = tid >> 6, wr = w >> 2, wc = w & 3, h = lane >> 5, p = lane & 31;
    int* eidb = (int*)(ws + O_EID) + (size_t)row0 * 128;
    float* gateb = (float*)(ws + O_GATE) + (size_t)row0 * 128;
    const u16* keys = (const u16*)(ws + O_KEYS);
    __syncthreads();
#pragma unroll
    for (int mb = 0; mb < 4; ++mb)
#pragma unroll
      for (int nb = 0; nb < 2; ++nb)
#pragma unroll
        for (int g = 0; g < 4; ++g) {
          u32x2 r = {pack2(AS(nb, mb)[4 * g], AS(nb, mb)[4 * g + 1]), pack2(AS(nb, mb)[4 * g + 2], AS(nb, mb)[4 * g + 3])};
          *(u32x2*)(Q2 + (wr * 128 + mb * 32 + p) * LDQ2 + wc * 64 + nb * 32 + 8 * g + 4 * h) = r;
        }
    unsigned L0[16], L1[16];
#pragma unroll
    for (int ck = 0; ck < 4; ++ck) {
      const int c = ck >> 1, kh = ck & 1;
      __syncthreads();
#pragma unroll
      for (int i = 0; i < 2; ++i) {
        const int id = tid + NTHR * i, kr = id >> 4, kc = id & 15;
        const u32x4 v = *(const u32x4*)(keys + (size_t)((hh * 2 + c) * 128 + kh * 64 + kr) * 128 + kc * 8);
        *(u32x4*)(Kt + kr * 128 + ((kc ^ (kr & 15)) << 3)) = v;
      }
      __syncthreads();
#pragma unroll
      for (int kb2 = 0; kb2 < 2; ++kb2) {
        f32x16 sc;
#pragma unroll
        for (int i = 0; i < 16; ++i) sc[i] = 0.f;
        const int kr = kb2 * 32 + p;
#pragma unroll
        for (int s = 0; s < 8; ++s) {
          bf16x8 a = ld8(Kt + kr * 128 + (((2 * s + h) ^ (kr & 15)) << 3));
          bf16x8 bq = ld8(Q2 + (w * 32 + p) * LDQ2 + c * 128 + 16 * s + 8 * h);
          sc = MFMA32(a, bq, sc);
        }
        unsigned Nk[16];
#pragma unroll
        for (int i = 0; i < 16; ++i) {
          const int key = kh * 64 + kb2 * 32 + crow(i, h);
          Nk[i] = (okey(sc[i]) & ~127u) | (unsigned)(127 - key);
        }
        sort16_desc(Nk);
        if (kh == 0 && kb2 == 0) {
#pragma unroll
          for (int i = 0; i < 16; ++i) L1[i] = Nk[i];
        } else {
          merge_top16(L1, Nk);
        }
      }
      if (kh == 1) {
        unsigned Pn[16];
#pragma unroll
        for (int i = 0; i < 16; ++i) Pn[i] = (unsigned)__shfl_xor((int)L1[i], 32);
        merge_top16(L1, Pn);
        if (c == 0) {
#pragma unroll
          for (int i = 0; i < 16; ++i) L0[i] = L1[i];
        }
      }
    }
    {
      const int role = h;
      const int half = 0, token = w * 32 + p;
      (void)half;
      float v0[16], v1[16];
#pragma unroll
      for (int i = 0; i < 16; ++i) { v0[i] = okey_inv(L0[i] & ~127u); v1[i] = okey_inv(L1[i] & ~127u); }
      unsigned C[16];
#pragma unroll
      for (int i = 0; i < 16; ++i) C[i] = 0u;
#pragma unroll
      for (int i = 0; i < 16; ++i)
#pragma unroll
        for (int j = 0; j < 16; ++j)
          if ((i + 1) * (j + 1) <= 16) ins16(C, (okey(v0[i] + v1[j]) & ~255u) | (unsigned)(255 - (i * 16 + j)));
      float sv[16];
      int ev[16];
      const float mxs = okey_inv(C[0] & ~255u);
      float ssum = 0.f;
#pragma unroll
      for (int k = 0; k < 16; ++k) {
        const int pos = 255 - (int)(C[k] & 255u);
        const int pi = pos >> 4, pj = pos & 15;
        unsigned a0 = 0, a1 = 0;
#pragma unroll
        for (int q = 0; q < 16; ++q) { a0 = (pi == q) ? L0[q] : a0; a1 = (pj == q) ? L1[q] : a1; }
        ev[k] = (127 - (int)(a0 & 127u)) * 128 + (127 - (int)(a1 & 127u));
        sv[k] = __expf(okey_inv(C[k] & ~255u) - mxs);
        ssum += sv[k];
      }
      const float inv = 1.f / ssum;
      const size_t o = (size_t)token * 128 + hh * 16;
      if (role == 0) {
#pragma unroll
        for (int k = 0; k < 16; k += 4) {
          int4 e4 = {ev[k], ev[k + 1], ev[k + 2], ev[k + 3]};
          *(int4*)(eidb + o + k) = e4;
        }
      } else {
#pragma unroll
        for (int k = 0; k < 16; k += 4) {
          float4 g4 = {sv[k] * inv, sv[k + 1] * inv, sv[k + 2] * inv, sv[k + 3] * inv};
          *(float4*)(gateb + o + k) = g4;
        }
      }
    }
  }
}

DI float dpp_xor1(float x) {
  return __int_as_float(__builtin_amdgcn_update_dpp(0, __float_as_int(x), 0xB1, 0xF, 0xF, true));
}
DI float dpp_ror8(float x) {
  return __int_as_float(__builtin_amdgcn_update_dpp(0, __float_as_int(x), 0x128, 0xF, 0xF, true));
}
DI unsigned cvt8(u32x4 x, int lo) {
  return pack_fp8x4(__uint_as_float(x[lo] << 16) * X_SCALE, __uint_as_float(x[lo] & 0xffff0000u) * X_SCALE,
                    __uint_as_float(x[lo + 1] << 16) * X_SCALE, __uint_as_float(x[lo + 1] & 0xffff0000u) * X_SCALE);
}
DI void chain_gather(const Params& P, char* smem, int row0) {
  char* ws = launder(P.ws);
  const int tid = launder_tid(), lane = tid & 63, w = tid >> 6;
  const float* pre1 = (const float*)(ws + O_PRE1) + (size_t)row0 * 1024;
  float* outp = P.out + (size_t)row0 * 1024;
  const u16* h1b = (const u16*)(ws + O_H1B) + (size_t)row0 * 1024;
  const u16* ple = (const u16*)(ws + O_PLE) + (size_t)row0 * 1024;
  const int* eidb = (const int*)(ws + O_EID) + (size_t)row0 * 128;
  const float* gateb = (const float*)(ws + O_GATE) + (size_t)row0 * 128;
  u16* hid = (u16*)smem + w * 4096;
  u16* eid16 = (u16*)(smem + 65536) + w * 4096;
  const unsigned char* U = (const unsigned char*)(ws + O_U);
  const unsigned char* V = (const unsigned char*)(ws + O_V);
  __syncthreads();
  {
    const int4* src4 = (const int4*)(eidb + (size_t)(w * 32) * 128);
#pragma unroll 4
    for (int i = lane; i < 1024; i += 64) {
      const int4 e4 = src4[i];
      u32x2 pk = {(unsigned)e4.x | ((unsigned)e4.y << 16), (unsigned)e4.z | ((unsigned)e4.w << 16)};
      *(u32x2*)(eid16 + i * 4) = pk;
    }
  }
  {
    const int n16 = lane & 15, quad = lane >> 4, m8 = n16 >> 1, part = n16 & 1;
    const u16* ebase = eid16 + m8;
    const unsigned char* xbase = (const unsigned char*)(ws + O_X8) + (size_t)(row0 + w * 32) * 1024 + part * 64 + 16 * quad;
    const unsigned char* Ub = U + part * 64 + 16 * quad;
#define U_LOADE(ST, GO, E)                                                  \
  {                                                                         \
    const u16* er_ = ebase + ((ST) & 31) * 128 + 8 * (GO);                  \
    _Pragma("unroll") for (int g = 0; g < 8; ++g) E[g] = er_[8 * g];        \
  }
#define U_LOADR(ST, E, RA, XV)                                                         \
  {                                                                                    \
    const unsigned char* us_ = Ub + (size_t)((ST) >> 5) * 2097152;                     \
    _Pragma("unroll") for (int g = 0; g < 8; ++g) RA[g] = *(const u32x4*)(us_ + (size_t)E[g] * 128); \
    XV = *(const u32x4*)(xbase + ((ST) & 31) * 1024 + ((ST) >> 5) * 128);              \
  }
#define U_COMP(ST, GO, RA, XV)                                                                               \
  {                                                                                                          \
    const u32x2 xl_ = {XV[0], XV[1]}, xh_ = {XV[2], XV[3]};                                                  \
    const long xlo = __builtin_bit_cast(long, xl_), xhi = __builtin_bit_cast(long, xh_);                     \
    u16* hp_ = hid + ((ST) & 31) * 128 + 2 * quad + 8 * (GO);                                                \
    _Pragma("unroll") for (int g = 0; g < 8; ++g) {                                                          \
      f32x4 acc_ = (f32x4){0.f, 0.f, 0.f, 0.f};                                                              \
      const u32x2 a0_ = {RA[g][0], RA[g][1]}, a1_ = {RA[g][2], RA[g][3]};                                    \
      acc_ = __builtin_amdgcn_mfma_f32_16x16x32_fp8_fp8(__builtin_bit_cast(long, a0_), xlo, acc_, 0, 0, 0);  \
      acc_ = __builtin_amdgcn_mfma_f32_16x16x32_fp8_fp8(__builtin_bit_cast(long, a1_), xhi, acc_, 0, 0, 0);  \
      const float t1_ = dpp_xor1(acc_[1]), t3_ = dpp_xor1(acc_[3]);                                          \
      if (n16 == 0) {                                                                                        \
        float h0_ = acc_[0] + t1_, h1_ = acc_[2] + t3_;                                                      \
        if ((ST) >= 32) {                                                                                    \
          const unsigned pk_ = *(const unsigned*)(hp_ + 8 * g);                                              \
          h0_ += __uint_as_float(pk_ << 16);                                                                 \
          h1_ += __uint_as_float(pk_ & 0xffff0000u);                                                         \
        }                                                                                                    \
        *(unsigned*)(hp_ + 8 * g) = pack2(h0_, h1_);                                                         \
      }                                                                                                      \
    }                                                                                                        \
  }
    int eA[8], eB[8];
    u32x4 rA[8], rB[8], xA, xB;
    U_LOADE(0, 0, eA);
    U_LOADE(0, 8, eB);
    U_LOADR(0, eA, rA, xA);
#pragma unroll 1
    for (int st = 0; st < 256; ++st) {
      if (st + 1 < 256) U_LOADE(st + 1, 0, eA);
      U_LOADR(st, eB, rB, xB);
      U_COMP(st, 0, rA, xA);
      if (st + 1 < 256) {
        U_LOADE(st + 1, 8, eB);
        U_LOADR(st + 1, eA, rA, xA);
      }
      U_COMP(st, 8, rB, xB);
    }
#undef U_LOADE
#undef U_LOADR
#undef U_COMP
#pragma unroll 4
    for (int i = 0; i < 32; ++i) {
      const float* gp = gateb + (size_t)(w * 32 + i) * 128;
#pragma unroll
      for (int hf = 0; hf < 2; ++hf) {
        const float hv = bf2f(hid[i * 128 + hf * 64 + lane]) * (1.f / (U_SCALE * X_SCALE));
        hid[i * 128 + hf * 64 + lane] = f2bf(0.5f * hv * (1.f + erff(hv * 0.7071067811865476f)) * gp[hf * 64 + lane] * (1.f / V_SCALE));
      }
    }
  }
  {
    const int rsub = lane >> 3, ch = lane & 7;
    const bool b5 = lane & 32, b4 = lane & 16, b3 = lane & 8;
    const u16* ebase = eid16 + rsub;
    const unsigned char* Vb = V + 16 * ch;
    const int colo = ch * 16 + (b5 ? 8 : 0) + (b4 ? 4 : 0) + (b3 ? 2 : 0);
#define V_LOADE(ST, IO, E)                                                        \
  {                                                                               \
    const u16* er_ = ebase + ((ST) & 31) * 128 + 8 * (IO);                        \
    _Pragma("unroll") for (int it = 0; it < 8; ++it) E[it] = er_[8 * it];         \
  }
#define V_LOADR(ST, E, R)                                                                \
  {                                                                                      \
    const unsigned char* vs_ = Vb + (size_t)((ST) >> 5) * 2097152;                       \
    _Pragma("unroll") for (int it = 0; it < 8; ++it) R[it] = *(const u32x4*)(vs_ + (size_t)E[it] * 128); \
  }
#define V_ACC(ST, IO, R)                                                                  \
  {                                                                                       \
    const u16* ap_ = hid + ((ST) & 31) * 128 + rsub + 8 * (IO);                           \
    _Pragma("unroll") for (int it = 0; it < 8; ++it) {                                    \
      const float sa = bf2f(ap_[8 * it]);                                                 \
      _Pragma("unroll") for (int q = 0; q < 4; ++q) {                                     \
        const f32v2 lo = __builtin_amdgcn_cvt_pk_f32_fp8((int)R[it][q], false);           \
        const f32v2 hi = __builtin_amdgcn_cvt_pk_f32_fp8((int)R[it][q], true);            \
        o[4 * q] += sa * lo[0];                                                           \
        o[4 * q + 1] += sa * lo[1];                                                       \
        o[4 * q + 2] += sa * hi[0];                                                       \
        o[4 * q + 3] += sa * hi[1];                                                       \
      }                                                                                   \
    }                                                                                     \
  }
    int eA[8], eB[8];
    u32x4 rA[8], rB[8];
    V_LOADE(0, 0, eA);
    V_LOADE(0, 8, eB);
    V_LOADR(0, eA, rA);
#pragma unroll 1
    for (int st = 0; st < 256; ++st) {
      float o[16];
#pragma unroll
      for (int k = 0; k < 16; ++k) o[k] = 0.f;
      if (st + 1 < 256) V_LOADE(st + 1, 0, eA);
      const size_t po = (size_t)(w * 32 + (st & 31)) * 1024 + (st >> 5) * 128 + colo;
      const float2 hv = *(const float2*)(pre1 + po);
      const unsigned pl = *(const unsigned*)(ple + po);
      V_LOADR(st, eB, rB);
      V_ACC(st, 0, rA);
      if (st + 1 < 256) {
        V_LOADE(st + 1, 8, eB);
        V_LOADR(st + 1, eA, rA);
      }
      V_ACC(st, 8, rB);
      float t8[8], t4[4], t2[2];
#pragma unroll
      for (int k = 0; k < 8; ++k) {
        const float snd = b5 ? o[k] : o[8 + k];
        const float keep = b5 ? o[8 + k] : o[k];
        t8[k] = keep + __shfl_xor(snd, 32);
      }
#pragma unroll
      for (int k = 0; k < 4; ++k) {
        const float snd = b4 ? t8[k] : t8[4 + k];
        const float keep = b4 ? t8[4 + k] : t8[k];
        t4[k] = keep + __shfl_xor(snd, 16);
      }
#pragma unroll
      for (int k = 0; k < 2; ++k) {
        const float snd = b3 ? t4[k] : t4[2 + k];
        const float keep = b3 ? t4[2 + k] : t4[k];
        t2[k] = keep + dpp_ror8(snd);
      }
      float2 y;
      y.x = ALPHA * hv.x + __uint_as_float(pl << 16) + t2[0];
      y.y = ALPHA * hv.y + __uint_as_float(pl & 0xffff0000u) + t2[1];
      *(float2*)(outp + po) = y;
    }
#undef V_LOADE
#undef V_LOADR
#undef V_ACC
  }
  __syncthreads();
  float4 nx[4];
#pragma unroll
  for (int q = 0; q < 4; ++q) nx[q] = *(const float4*)(outp + (size_t)(w * 32) * 1024 + q * 256 + lane * 4);
  for (int i = 0; i < 32; ++i) {
    const int r = w * 32 + i;
    float v[16];
    float sum = 0.f;
    float4 cx[4];
#pragma unroll
    for (int q = 0; q < 4; ++q) cx[q] = nx[q];
    if (i + 1 < 32) {
#pragma unroll
      for (int q = 0; q < 4; ++q) nx[q] = *(const float4*)(outp + (size_t)(r + 1) * 1024 + q * 256 + lane * 4);
    }
#pragma unroll
    for (int q = 0; q < 4; ++q) {
      float4 a = cx[q];
      v[4 * q] = a.x; v[4 * q + 1] = a.y; v[4 * q + 2] = a.z; v[4 * q + 3] = a.w;
      sum += a.x + a.y + a.z + a.w;
    }
    const float mean = wave_sum(sum) * (1.f / 1024.f);
    float sq = 0.f;
#pragma unroll
    for (int e = 0; e < 16; ++e) { v[e] -= mean; sq += v[e] * v[e]; }
    const float rstd = rsqrtf(wave_sum(sq) * (1.f / 1024.f) + LN_EPS);
#pragma unroll
    for (int q = 0; q < 4; ++q) {
      const int c = q * 256 + lane * 4;
      float4 g = *(const float4*)(P.ln2_g + c);
      float4 bb = *(const float4*)(P.ln2_b + c);
      float4 y;
      y.x = v[4 * q] * rstd * g.x + bb.x; y.y = v[4 * q + 1] * rstd * g.y + bb.y;
      y.z = v[4 * q + 2] * rstd * g.z + bb.z; y.w = v[4 * q + 3] * rstd * g.w + bb.w;
      *(float4*)(P.out + (size_t)(row0 + r) * 1024 + c) = y;
    }
  }
}

__global__ void __launch_bounds__(NTHR) fwd_megakernel(Params P) {
  __shared__ __attribute__((aligned(16))) char smem[L_TOTAL];
  __shared__ int s_item;
  cg::grid_group grid = cg::this_grid();
  char* ws = P.ws;
  phase0(P, smem);
  for (int rb = blockIdx.x; rb < 256; rb += gridDim.x) ln_emb_rows(P, smem, rb * 256);
  grid.sync();
  {
    f32x16 acc[8];
    const bool xcd_order = gridDim.x == 256;
    const int nunits = xcd_order ? 20 : 20 * ((256 - (int)blockIdx.x + (int)gridDim.x - 1) / (int)gridDim.x);
    const int xq = blockIdx.x & 7, jq = blockIdx.x >> 3;
    for (int u = 0; u < nunits; ++u) {
      int rb, T;
      if (xcd_order) { rb = xq + 8 * (8 * (u & 3) + (jq & 7)); T = 4 * (u >> 2) + (jq >> 3); }
      else { rb = blockIdx.x + (u / 20) * gridDim.x; T = u % 20; }
      const int row0 = rb * 256;
      const u16* Ablk = (const u16*)(ws + O_H0) + (size_t)row0 * 1024;
      const int ctw = T < 4 ? 2 * T : 2 * T - 4;
      const u16* Bt = (const u16*)(ws + O_WIN) + (size_t)ctw * 128 * 1024;
      const bool sw = T < 4 || (T >= 10 && T < 18);
      zero_acc8(acc);
      if (sw) gemm_loop<true>(Ablk, 1024, Bt, 1024, 1024, smem, acc);
      else gemm_loop<false>(Ablk, 1024, Bt, 1024, 1024, smem, acc);
      p1_epilogue(P, T, row0, smem, acc);
    }
  }
  grid.sync();
  if (threadIdx.x == 0) s_item = atomicAdd((int*)(ws + O_CTR), 1);
  while (true) {
    __syncthreads();
    const int item = s_item;
    __syncthreads();
    if (item >= 128 + 2048) break;
    int nxt = 0;
    if (threadIdx.x == 0) nxt = atomicAdd((int*)(ws + O_CTR), 1);
    if (item < 128) retention_item(P, smem, item);
    else attention_item(P, smem, item - 128);
    if (threadIdx.x == 0) s_item = nxt;
  }
  grid.sync();
  for (int rb = blockIdx.x; rb < 256; rb += gridDim.x) {
    const int row0 = rb * 256;
    chain_gemms(P, smem, row0);
    __syncthreads();
    chain_ln1(P, smem, row0);
    __syncthreads();
    chain_ple(P, smem, row0);
    chain_topk(P, smem, row0);
  }
  __syncthreads();
  for (int rb = blockIdx.x; rb < 256; rb += gridDim.x) chain_gather(P, smem, rb * 256);
}

extern "C" void kernel_launch(void* const* d_in, const int* in_sizes, int n_in, void* d_out, int out_size, void* d_ws,
                              size_t ws_size, hipStream_t stream) {
  static int grid_blocks = 0;
  if (!grid_blocks) {
    int dev = 0, cus = 0, per_cu = 0;
    hipGetDevice(&dev);
    hipDeviceGetAttribute(&cus, hipDeviceAttributeMultiprocessorCount, dev);
    hipOccupancyMaxActiveBlocksPerMultiprocessor(&per_cu, fwd_megakernel, NTHR, 0);
    if (per_cu > 1) per_cu = 1;
    grid_blocks = cus * per_cu;
    if (grid_blocks > 256) grid_blocks = 256;
  }
  Params p{};
  const float** fp = (const float**)&p;
  for (int i = 0; i < 21; ++i) fp[i] = (const float*)d_in[i];
  p.out = (float*)d_out;
  p.ws = (char*)d_ws;
  void* args[] = {&p};
  hipError_t e = hipLaunchCooperativeKernel((void*)fwd_megakernel, dim3(grid_blocks), dim3(NTHR), args, 0, stream);
  if (e != hipSuccess) fprintf(stderr, "cooperative launch failed: %s (grid %d)\n", hipGetErrorString(e), grid_blocks);
}
```

```cpp
#include <hip/hip_runtime.h>
#include <hip/hip_cooperative_groups.h>
#include <cstdio>
namespace cg = cooperative_groups;

typedef unsigned short u16;
typedef short bf16x8 __attribute__((ext_vector_type(8)));
typedef float f32x16 __attribute__((ext_vector_type(16)));
typedef float f32x4 __attribute__((ext_vector_type(4)));
typedef unsigned u32x4 __attribute__((ext_vector_type(4)));
typedef unsigned u32x2 __attribute__((ext_vector_type(2)));
#define DI __device__ __forceinline__
#define MFMA32(a, b, c) __builtin_amdgcn_mfma_f32_32x32x16_bf16((a), (b), (c), 0, 0, 0)
#define MFMA16(a, b, c) __builtin_amdgcn_mfma_f32_16x16x32_bf16((a), (b), (c), 0, 0, 0)

constexpr int NTHR = 512;
constexpr float ALPHA = 1.189207115002721f;
constexpr float LN_EPS = 1e-5f;
constexpr size_t MB = 1u << 20;
constexpr size_t O_WIN = 0, O_WGF = 9 * MB, O_WGR = 11 * MB, O_WRO = 13 * MB, O_WFO = 15 * MB, O_WO = 16 * MB,
                 O_WQ = 18 * MB, O_WG = 22 * MB, O_WPLE = 24 * MB, O_KEYS = 24 * MB + MB / 2, O_ROPE = 25 * MB,
                 O_LOGF = 26 * MB, O_CTR = 28 * MB, O_U = 32 * MB, O_V = 64 * MB, O_PB = 96 * MB, O_H0 = 128 * MB,
                 O_QR = 256 * MB, O_KR = 320 * MB, O_VT = 384 * MB, O_KTD = 512 * MB, O_FK = 576 * MB,
                 O_RG = 640 * MB, O_FQ = 768 * MB, O_FVT = 832 * MB;
constexpr size_t O_YF = 960 * MB;
constexpr size_t O_X8 = 896 * MB;
constexpr size_t O_MERGED = O_QR, O_PRE1 = O_VT, O_H1B = O_H0, O_PLE = O_RG, O_EID = O_FVT, O_GATE = O_FVT + 32 * MB;
constexpr int L_STG = 65536, L_Q2 = 0, L_WFF = 98304, L_TOTAL = 151552;
constexpr int LDK = 72;
constexpr int LDQ = 136;
constexpr int LDQ2 = 264;

struct Params {
  const float *x, *p, *ln_emb_g, *ln_emb_b, *w_in, *b_forget, *b_bg, *w_ret_o, *w_fox_o, *w_out, *ln1_g, *ln1_b,
      *w_peer_q, *sub_keys, *peer_u, *peer_v, *w_ple_gate, *b_ple_gate, *w_ple, *ln2_g, *ln2_b;
  float* out;
  char* ws;
};

DI char* launder(char* p) {
  size_t z = 0;
  asm volatile("" : "+s"(z));
  return p + z;
}
DI int launder_tid() {
  int t = threadIdx.x;
  asm volatile("" : "+v"(t));
  return t;
}
DI float bf2f(u16 v) { return __uint_as_float((unsigned)v << 16); }
DI u16 f2bf(float x) {
  unsigned u = __float_as_uint(x);
  u += 0x7fffu + ((u >> 16) & 1u);
  return (u16)(u >> 16);
}
typedef __bf16 bf16v2 __attribute__((ext_vector_type(2)));
typedef float f32v2 __attribute__((ext_vector_type(2)));
DI unsigned pack2(float a, float b) {
  f32v2 v = {a, b};
  return __builtin_bit_cast(unsigned, __builtin_convertvector(v, bf16v2));
}
constexpr float U_SCALE = 64.f, V_SCALE = 16.f, X_SCALE = 8.f;
DI unsigned pack_fp8x4(float a, float b, float c, float d) {
  int w = __builtin_amdgcn_cvt_pk_fp8_f32(a, b, 0, false);
  w = __builtin_amdgcn_cvt_pk_fp8_f32(c, d, w, true);
  return (unsigned)w;
}
DI int crow(int i, int h) { return (i & 3) + 8 * (i >> 2) + 4 * h; }
DI float wave_sum(float v) {
  v += __int_as_float(__builtin_amdgcn_update_dpp(0, __float_as_int(v), 0xB1, 0xF, 0xF, true));
  v += __int_as_float(__builtin_amdgcn_update_dpp(0, __float_as_int(v), 0x4E, 0xF, 0xF, true));
  v += __int_as_float(__builtin_amdgcn_update_dpp(0, __float_as_int(v), 0x124, 0xF, 0xF, true));
  v += __int_as_float(__builtin_amdgcn_update_dpp(0, __float_as_int(v), 0x128, 0xF, 0xF, true));
  v += __shfl_xor(v, 16);
  v += __shfl_xor(v, 32);
  return v;
}
DI float half_sum(float v) {
#pragma unroll
  for (int o = 16; o; o >>= 1) v += __shfl_xor(v, o);
  return v;
}
DI float sigmoidf_(float x) { return 1.f / (1.f + __expf(-x)); }
DI bf16x8 pack8(const f32x16& x, int s) {
  u32x4 p;
  p[0] = pack2(x[8 * s + 0], x[8 * s + 1]);
  p[1] = pack2(x[8 * s + 2], x[8 * s + 3]);
  p[2] = pack2(x[8 * s + 4], x[8 * s + 5]);
  p[3] = pack2(x[8 * s + 6], x[8 * s + 7]);
  return __builtin_bit_cast(bf16x8, p);
}
DI bf16x8 ld8(const u16* p) { return *(const bf16x8*)p; }
DI bf16x8 join44(u32x2 a, u32x2 b) {
  u32x4 r = {a[0], a[1], b[0], b[1]};
  return __builtin_bit_cast(bf16x8, r);
}
DI void zero_acc(f32x16 (&acc)[2][2]) {
#pragma unroll
  for (int a = 0; a < 2; ++a)
#pragma unroll
    for (int b = 0; b < 2; ++b)
#pragma unroll
      for (int i = 0; i < 16; ++i) acc[a][b][i] = 0.f;
}

DI void glds16(const void* g, void* l) {
  __builtin_amdgcn_global_load_lds((const unsigned*)g, (__attribute__((address_space(3))) unsigned*)l, 16, 0, 0);
}
#define AN(mb, nb) acc[(mb) * 2 + (nb)]
#define AS(nb, mb) acc[(nb) * 4 + (mb)]
DI void zero_acc8(f32x16 (&acc)[8]) {
#pragma unroll
  for (int a = 0; a < 8; ++a)
#pragma unroll
    for (int i = 0; i < 16; ++i) acc[a][i] = 0.f;
}
template <bool SWAP>
DI void gemm_loop(const u16* __restrict__ A, int lda, const u16* __restrict__ B, int ldb, int K, char* smem,
                  f32x16 (&acc)[8]) {
  const int tid = launder_tid(), lane = tid & 63, w = tid >> 6, wr = w >> 2, wc = w & 3;
  const int lr = lane >> 3, slot = lane & 7;
  const int ce = (slot ^ (lr >> 1)) * 8, co = (slot ^ (4 + (lr >> 1))) * 8;
  const u16* ae = A + (size_t)(w * 32 + lr) * lda + ce;
  const u16* ao = A + (size_t)(w * 32 + lr) * lda + co;
  const u16* be = B + (size_t)(w * 32 + lr) * ldb + ce;
  const u16* bo = B + (size_t)(w * 32 + lr) * ldb + co;
#define AGP(j) (((j) & 1 ? ao : ae) + (size_t)((j) * 8) * lda)
#define BGP(j) (((j) & 1 ? bo : be) + (size_t)((j) * 8) * ldb)
  char* dA = smem + w * 4096;
  char* dB = smem + 32768 + w * 4096;
  const int nk = K >> 6;
  __syncthreads();
#pragma unroll
  for (int j = 0; j < 4; ++j) glds16(AGP(j), dA + j * 1024);
#pragma unroll
  for (int j = 0; j < 4; ++j) glds16(BGP(j), dB + j * 1024);
  const int ra_row = wr * 128 + (lane & 31), rb_row = wc * 64 + (lane & 31), hq = lane >> 5;
  const int sa = (ra_row >> 1) & 7, sb = (rb_row >> 1) & 7;
  const unsigned sbase = (unsigned)(size_t)smem;
  unsigned oa[4], ob[4];
#pragma unroll
  for (int ks = 0; ks < 4; ++ks) {
    oa[ks] = sbase + ra_row * 128 + (((ks * 2 + hq) ^ sa) << 4);
    ob[ks] = sbase + 32768 + rb_row * 128 + (((ks * 2 + hq) ^ sb) << 4);
  }
#define RD6(A0, A1, A2, A3, B0, B1, KS)                                                                            \
  asm volatile("ds_read_b128 %0, %6\n\tds_read_b128 %1, %6 offset:4096\n\tds_read_b128 %2, %6 offset:8192\n\t"     \
               "ds_read_b128 %3, %6 offset:12288\n\tds_read_b128 %4, %7\n\tds_read_b128 %5, %7 offset:4096"        \
               : "=&v"(A0), "=&v"(A1), "=&v"(A2), "=&v"(A3), "=&v"(B0), "=&v"(B1)                                  \
               : "v"(oa[KS] + so), "v"(ob[KS] + so)                                                                \
               : "memory")
#define WT6(A0, A1, A2, A3, B0, B1) \
  asm volatile("s_waitcnt lgkmcnt(0)" : "+v"(A0), "+v"(A1), "+v"(A2), "+v"(A3), "+v"(B0), "+v"(B1)::"memory")
#define MM8(A0, A1, A2, A3, B0, B1)             \
  if (SWAP) {                                   \
    AS(0, 0) = MFMA32(B0, A0, AS(0, 0));        \
    AS(0, 1) = MFMA32(B0, A1, AS(0, 1));        \
    AS(0, 2) = MFMA32(B0, A2, AS(0, 2));        \
    AS(0, 3) = MFMA32(B0, A3, AS(0, 3));        \
    AS(1, 0) = MFMA32(B1, A0, AS(1, 0));        \
    AS(1, 1) = MFMA32(B1, A1, AS(1, 1));        \
    AS(1, 2) = MFMA32(B1, A2, AS(1, 2));        \
    AS(1, 3) = MFMA32(B1, A3, AS(1, 3));        \
  } else {                                      \
    AN(0, 0) = MFMA32(A0, B0, AN(0, 0));        \
    AN(0, 1) = MFMA32(A0, B1, AN(0, 1));        \
    AN(1, 0) = MFMA32(A1, B0, AN(1, 0));        \
    AN(1, 1) = MFMA32(A1, B1, AN(1, 1));        \
    AN(2, 0) = MFMA32(A2, B0, AN(2, 0));        \
    AN(2, 1) = MFMA32(A2, B1, AN(2, 1));        \
    AN(3, 0) = MFMA32(A3, B0, AN(3, 0));        \
    AN(3, 1) = MFMA32(A3, B1, AN(3, 1));        \
  }
#pragma unroll 1
  for (int kt = 0; kt < nk; ++kt) {
    asm volatile("s_waitcnt vmcnt(0)" ::: "memory");
    asm volatile("s_waitcnt lgkmcnt(0)" ::: "memory");
    __builtin_amdgcn_s_barrier();
    if (kt + 1 < nk) {
      const int s2 = (kt + 1) & 1;
      const int ko = (kt + 1) * 64;
#pragma unroll
      for (int j = 0; j < 4; ++j) glds16(AGP(j) + ko, dA + s2 * L_STG + j * 1024);
#pragma unroll
      for (int j = 0; j < 4; ++j) glds16(BGP(j) + ko, dB + s2 * L_STG + j * 1024);
    }
    const unsigned so = (unsigned)((kt & 1) * L_STG);
    bf16x8 a0, a1, a2, a3, b0, b1;
#pragma unroll
    for (int ks = 0; ks < 4; ++ks) {
      RD6(a0, a1, a2, a3, b0, b1, ks);
      WT6(a0, a1, a2, a3, b0, b1);
      MM8(a0, a1, a2, a3, b0, b1);
    }
  }
#undef RD6
#undef AGP
#undef BGP
#undef WT6
#undef MM8
}

DI void phase0(const Params& P, char* smem) {
  char* ws = launder(P.ws);
  const int tid = launder_tid(), nb = gridDim.x, bid = blockIdx.x;
  float* tl = (float*)smem;
  for (int tile = bid; tile < 3136; tile += nb) {
    const float* W;
    int ld, K, srcbase = 0, ntn = 16, t;
    u16* dst;
    bool rot = false;
    if (tile < 1152) { t = tile; W = P.w_in; ld = 6664; K = 1024; ntn = 72; dst = (u16*)(ws + O_WIN); rot = true; }
    else if (tile < 1408) { t = tile - 1152; W = P.w_in; ld = 6664; K = 1024; srcbase = 5640; dst = (u16*)(ws + O_WGF); }
    else if (tile < 1664) { t = tile - 1408; W = P.w_in; ld = 6664; K = 1024; srcbase = 4616; dst = (u16*)(ws + O_WGR); }
    else if (tile < 1920) { t = tile - 1664; W = P.w_ret_o; ld = 1024; K = 1024; dst = (u16*)(ws + O_WRO); }
    else if (tile < 2048) { t = tile - 1920; W = P.w_fox_o; ld = 1024; K = 512; dst = (u16*)(ws + O_WFO); }
    else if (tile < 2304) { t = tile - 2048; W = P.w_out; ld = 1024; K = 1024; dst = (u16*)(ws + O_WO); }
    else if (tile < 2816) { t = tile - 2304; W = P.w_peer_q; ld = 2048; K = 1024; ntn = 32; dst = (u16*)(ws + O_WQ); }
    else if (tile < 3072) { t = tile - 2816; W = P.w_ple_gate; ld = 1024; K = 1024; dst = (u16*)(ws + O_WG); }
    else { t = tile - 3072; W = P.w_ple; ld = 1024; K = 256; dst = (u16*)(ws + O_WPLE); }
    const int n0 = (t % ntn) * 64, k0 = (t / ntn) * 64;
    {
      const int nn = tid & 63, kq = tid >> 6;
      const int n = n0 + nn;
      int src = n;
      if (rot && n < 1024) {
        const int np = n & 127;
        src = (n & ~127) + (((np >> 6) << 5) | (np & 31)) + 64 * ((np >> 5) & 1);
      }
      src += srcbase;
#pragma unroll
      for (int i = 0; i < 8; ++i) {
        const int kk = kq + 8 * i;
        tl[kk * 65 + nn] = W[(size_t)(k0 + kk) * ld + src];
      }
    }
    __syncthreads();
    {
      const int kk = tid & 63, nq = tid >> 6;
#pragma unroll
      for (int i = 0; i < 8; ++i) {
        const int nn = nq + 8 * i;
        dst[(size_t)(n0 + nn) * K + k0 + kk] = f2bf(tl[kk * 65 + nn]);
      }
    }
    __syncthreads();
  }
  const int gt = bid * NTHR + tid, nt = nb * NTHR;
  for (int i = gt; i < 4194304; i += nt) {
    const int e = i >> 8, k4 = (i & 255) * 4;
    const size_t di = ((size_t)(k4 >> 7) * 2097152 + (size_t)e * 128 + (k4 & 127)) >> 2;
    float4 a = ((const float4*)P.peer_u)[i];
    ((unsigned*)(ws + O_U))[di] = pack_fp8x4(a.x * U_SCALE, a.y * U_SCALE, a.z * U_SCALE, a.w * U_SCALE);
    a = ((const float4*)P.peer_v)[i];
    ((unsigned*)(ws + O_V))[di] = pack_fp8x4(a.x * V_SCALE, a.y * V_SCALE, a.z * V_SCALE, a.w * V_SCALE);
    a = ((const float4*)P.p)[i];
    u32x2 r = {pack2(a.x, a.y), pack2(a.z, a.w)};
    ((u32x2*)(ws + O_PB))[i] = r;
  }
  for (int i = gt; i < 65536; i += nt) {
    float4 a = ((const float4*)P.sub_keys)[i];
    u32x2 r = {pack2(a.x, a.y), pack2(a.z, a.w)};
    ((u32x2*)(ws + O_KEYS))[i] = r;
  }
  for (int i = gt; i < 131072; i += nt) {
    const int s = i >> 6, f = i & 63;
    const float inv = exp2f(-(float)f * 0.20762050593046f);
    const float angf = (float)s * inv;
    const double a = (double)angf;
    const double n = __builtin_rint(a * 0.15915494309189535);
    const float r = (float)(a - n * 6.283185307179586);
    float2 cs;
    cs.x = __cosf(r);
    cs.y = __sinf(r);
    ((float2*)(ws + O_ROPE))[i] = cs;
  }
  if (gt == 0) *(int*)(ws + O_CTR) = 0;
}

DI void ln_emb_rows(const Params& P, char* smem, int row0) {
  char* ws = launder(P.ws);
  const int tid = launder_tid(), lane = tid & 63, w = tid >> 6;
  float* wffT = (float*)(smem + L_WFF);
  __syncthreads();
  for (int idx = tid; idx < 8192; idx += NTHR) {
    const int k = idx >> 3, j = idx & 7;
    wffT[j * 1024 + k] = P.w_in[(size_t)k * 6664 + 4608 + j];
  }
  __syncthreads();
  u16* h0 = (u16*)(ws + O_H0);
  float* logf_ = (float*)(ws + O_LOGF);
  float4 nx[4];
#pragma unroll
  for (int q = 0; q < 4; ++q) nx[q] = *(const float4*)(P.x + (size_t)(row0 + w * 32) * 1024 + q * 256 + lane * 4);
  for (int i = 0; i < 32; ++i) {
    const int t = row0 + w * 32 + i;
    float v[16];
    float sum = 0.f;
    float4 cx[4];
#pragma unroll
    for (int q = 0; q < 4; ++q) cx[q] = nx[q];
    if (i + 1 < 32) {
#pragma unroll
      for (int q = 0; q < 4; ++q) nx[q] = *(const float4*)(P.x + (size_t)(t + 1) * 1024 + q * 256 + lane * 4);
    }
#pragma unroll
    for (int q = 0; q < 4; ++q) {
      float4 a = cx[q];
      v[4 * q] = a.x; v[4 * q + 1] = a.y; v[4 * q + 2] = a.z; v[4 * q + 3] = a.w;
      sum += a.x + a.y + a.z + a.w;
    }
    const float mean = wave_sum(sum) * (1.f / 1024.f);
    float sq = 0.f;
#pragma unroll
    for (int e = 0; e < 16; ++e) { v[e] -= mean; sq += v[e] * v[e]; }
    const float rstd = rsqrtf(wave_sum(sq) * (1.f / 1024.f) + LN_EPS);
    float ff[8];
#pragma unroll
    for (int j = 0; j < 8; ++j) ff[j] = 0.f;
#pragma unroll
    for (int q = 0; q < 4; ++q) {
      const int c = q * 256 + lane * 4;
      float4 g = *(const float4*)(P.ln_emb_g + c);
      float4 bb = *(const float4*)(P.ln_emb_b + c);
      const float y0 = v[4 * q] * rstd * g.x + bb.x, y1 = v[4 * q + 1] * rstd * g.y + bb.y,
                  y2 = v[4 * q + 2] * rstd * g.z + bb.z, y3 = v[4 * q + 3] * rstd * g.w + bb.w;
      u32x2 r = {pack2(y0, y1), pack2(y2, y3)};
      *(u32x2*)(h0 + (size_t)t * 1024 + c) = r;
#pragma unroll
      for (int j = 0; j < 8; ++j) {
        float4 wv = *(const float4*)(wffT + j * 1024 + c);
        ff[j] += y0 * wv.x + y1 * wv.y + y2 * wv.z + y3 * wv.w;
      }
    }
    float mine = 0.f;
#pragma unroll
    for (int j = 0; j < 8; ++j) {
      const float s = wave_sum(ff[j]);
      mine = (lane == j) ? s : mine;
    }
    if (lane < 8) {
      const float z = mine + P.b_forget[lane];
      const float lf = fminf(z, 0.f) - log1pf(__expf(-fabsf(z)));
      const int b = t >> 11, s = t & 2047;
      logf_[(size_t)(b * 8 + lane) * 2048 + s] = lf;
    }
  }
}

DI void p1_epilogue(const Params& P, int T, int row0, char* smem, f32x16 (&acc)[8]) {
  char* ws = launder(P.ws);
  const int tid_ = launder_tid();
  const int lane = tid_ & 63, w = tid_ >> 6, wr = w >> 2, wc4 = w & 3, sub = wc4 >> 1, wc = wc4 & 1, h = lane >> 5, p = lane & 31;
  const int b = row0 >> 11, s0 = row0 & 2047;
  u16* T_ = (u16*)smem;
  __syncthreads();
  if (T < 4) {
    const float sc = T >= 2 ? 0.08838834764831845f : 1.f;
#pragma unroll
    for (int mb = 0; mb < 4; ++mb) {
      const int r = wr * 128 + mb * 32 + p;
      const float* rp = (const float*)(ws + O_ROPE) + (size_t)((s0 + r) * 64 + wc * 32 + 4 * h) * 2;
      u16* d = T_ + r * LDQ2 + sub * 128 + wc * 64 + 4 * h;
#pragma unroll
      for (int g = 0; g < 4; ++g) {
        const float4 c01 = *(const float4*)(rp + 16 * g);
        const float4 c23 = *(const float4*)(rp + 16 * g + 4);
        const float cs[4] = {c01.x, c01.z, c23.x, c23.z};
        const float sn[4] = {c01.y, c01.w, c23.y, c23.w};
        float o1[4], o2[4];
#pragma unroll
        for (int ii = 0; ii < 4; ++ii) {
          const float x1 = AS(0, mb)[4 * g + ii], x2 = AS(1, mb)[4 * g + ii];
          o1[ii] = (x1 * cs[ii] - x2 * sn[ii]) * sc;
          o2[ii] = (x2 * cs[ii] + x1 * sn[ii]) * sc;
        }
        u32x2 r1 = {pack2(o1[0], o1[1]), pack2(o1[2], o1[3])};
        u32x2 r2 = {pack2(o2[0], o2[1]), pack2(o2[2], o2[3])};
        *(u32x2*)(d + 8 * g) = r1;
        *(u32x2*)(d + 8 * g + 32) = r2;
      }
    }
  } else if (T < 6) {
    const int hd = 2 * (T - 4) + sub;
    const float lg = logf(1.f - exp2f(-5.f - (float)hd));
    const int f = wc * 32 + p;
#pragma unroll
    for (int mb = 0; mb < 4; ++mb) {
      const int rb0 = wr * 128 + mb * 32 + 4 * h;
      const float2* rp = (const float2*)(ws + O_ROPE) + (size_t)(s0 + rb0) * 64 + f;
      u16* d = T_ + (sub * 128 + wc * 64 + p) * LDQ2 + rb0;
#pragma unroll
      for (int g = 0; g < 4; ++g) {
        float o1[4], o2[4];
#pragma unroll
        for (int ii = 0; ii < 4; ++ii) {
          const float2 cs = rp[(8 * g + ii) * 64];
          const float x1 = AN(mb, 0)[4 * g + ii], x2 = AN(mb, 1)[4 * g + ii];
          const int s = s0 + rb0 + 8 * g + ii;
          const float kd = __expf(lg * (float)(127 - (s & 127))) * 0.08838834764831845f;
          o1[ii] = (x1 * cs.x - x2 * cs.y) * kd;
          o2[ii] = (x2 * cs.x + x1 * cs.y) * kd;
        }
        u32x2 r1 = {pack2(o1[0], o1[1]), pack2(o1[2], o1[3])};
        u32x2 r2 = {pack2(o2[0], o2[1]), pack2(o2[2], o2[3])};
        *(u32x2*)(d + 8 * g) = r1;
        *(u32x2*)(d + 32 * LDQ2 + 8 * g) = r2;
      }
    }
  } else if (T < 10 || T >= 18) {
#pragma unroll
    for (int mb = 0; mb < 4; ++mb)
#pragma unroll
      for (int nb = 0; nb < 2; ++nb)
#pragma unroll
        for (int g = 0; g < 4; ++g) {
          u32x2 r = {pack2(AN(mb, nb)[4 * g], AN(mb, nb)[4 * g + 1]), pack2(AN(mb, nb)[4 * g + 2], AN(mb, nb)[4 * g + 3])};
          *(u32x2*)(T_ + (wc4 * 64 + nb * 32 + p) * LDQ2 + wr * 128 + mb * 32 + 8 * g + 4 * h) = r;
        }
  } else {
    const int mode = T < 14 ? 0 : T < 16 ? 1 : 2;
#pragma unroll
    for (int mb = 0; mb < 4; ++mb)
#pragma unroll
      for (int nb = 0; nb < 2; ++nb)
#pragma unroll
        for (int g = 0; g < 4; ++g) {
          float x[4];
#pragma unroll
          for (int ii = 0; ii < 4; ++ii) {
            x[ii] = AS(nb, mb)[4 * g + ii];
            if (mode == 0) x[ii] = x[ii] * sigmoidf_(x[ii]);
            else if (mode == 1) x[ii] *= 0.125f;
          }
          u32x2 r = {pack2(x[0], x[1]), pack2(x[2], x[3])};
          *(u32x2*)(T_ + (wr * 128 + mb * 32 + p) * LDQ2 + wc4 * 64 + nb * 32 + 8 * g + 4 * h) = r;
        }
  }
  __syncthreads();
  u16* dst;
  size_t rstride;
  if (T < 2) { dst = (u16*)(ws + O_QR) + (size_t)row0 * 512 + T * 256; rstride = 512; }
  else if (T < 4) { dst = (u16*)(ws + O_KR) + (size_t)row0 * 512 + (T - 2) * 256; rstride = 512; }
  else if (T < 6) { dst = (u16*)(ws + O_KTD) + (size_t)((b * 4 + 2 * (T - 4)) * 128) * 2048 + s0; rstride = 2048; }
  else if (T < 10) { dst = (u16*)(ws + O_VT) + (size_t)((b * 4 + (T - 6)) * 256) * 2048 + s0; rstride = 2048; }
  else if (T < 14) { dst = (u16*)(ws + O_RG) + (size_t)row0 * 1024 + (T - 10) * 256; rstride = 1024; }
  else if (T < 16) { dst = (u16*)(ws + O_FQ) + (size_t)row0 * 512 + (T - 14) * 256; rstride = 512; }
  else if (T < 18) { dst = (u16*)(ws + O_FK) + (size_t)row0 * 512 + (T - 16) * 256; rstride = 512; }
  else { dst = (u16*)(ws + O_FVT) + (size_t)((b * 8 + (T - 18) * 4) * 64) * 2048 + s0; rstride = 2048; }
#pragma unroll 4
  for (int i = 0; i < 16; ++i) {
    const int id = tid_ + NTHR * i, r = id >> 5, kc = id & 31;
    *(u32x4*)(dst + (size_t)r * rstride + kc * 8) = *(const u32x4*)(T_ + r * LDQ2 + kc * 8);
  }
}

DI void retention_item(const Params& P, char* smem, int item) {
  char* ws = launder(P.ws);
  const int tid = launder_tid(), lane = tid & 63, w = tid >> 6, h = lane >> 5, p = lane & 31;
  const int b = item >> 2, hd = item & 3;
  u16* Qs = (u16*)smem;
  u16* Ps = (u16*)(smem + 34816);
  u16* Ks = (u16*)(smem + 69632);
  u16* KTs = (u16*)(smem + 104448);
  float* stats = (float*)(smem + 139264);
  float* mr = (float*)(smem + 147456);
  const u16* qr = (const u16*)(ws + O_QR);
  const u16* kr = (const u16*)(ws + O_KR);
  const u16* vt = (const u16*)(ws + O_VT) + (size_t)((b * 4 + hd) * 256 + w * 32 + p) * 2048 + 8 * h;
  const u16* ktd = (const u16*)(ws + O_KTD) + (size_t)((b * 4 + hd) * 128) * 2048;
  u16* rg = (u16*)(ws + O_RG);
  const float lg = logf(1.f - exp2f(-5.f - (float)hd));
  const float cd = __expf(lg * 128.f);
  f32x16 R[4], OT[4];
#pragma unroll
  for (int a = 0; a < 4; ++a)
#pragma unroll
    for (int i = 0; i < 16; ++i) R[a][i] = 0.f;
  const float lg0 = lg;
  for (int c = 0; c < 16; ++c) {
    const int t0 = b * 2048 + c * 128;
    float lg = lg0;
    asm volatile("" : "+v"(lg));
    __syncthreads();
    {
      u32x4 tq[4], tk[4], tt2[4];
#pragma unroll
      for (int i = 0; i < 4; ++i) {
        const int id = tid + NTHR * i, row = id >> 4, kc = id & 15;
        tq[i] = *(const u32x4*)(qr + (size_t)(t0 + row) * 512 + hd * 128 + kc * 8);
        tk[i] = *(const u32x4*)(kr + (size_t)(t0 + row) * 512 + hd * 128 + kc * 8);
        tt2[i] = *(const u32x4*)(ktd + (size_t)row * 2048 + c * 128 + kc * 8);
      }
#pragma unroll
      for (int i = 0; i < 4; ++i) {
        const int id = tid + NTHR * i, row = id >> 4, kc = id & 15;
        *(u32x4*)(Qs + row * LDQ + kc * 8) = tq[i];
        *(u32x4*)(Ks + row * LDQ + kc * 8) = tk[i];
        *(u32x4*)(KTs + row * LDQ + kc * 8) = tt2[i];
      }
    }
    __syncthreads();
#pragma unroll
    for (int tt = 0; tt < 2; ++tt) {
      const int id = w + 8 * tt, ib = id >> 2, jb = id & 3;
      f32x16 st;
#pragma unroll
      for (int i = 0; i < 16; ++i) st[i] = 0.f;
      if (jb <= ib) {
        const u16* kp = Ks + (jb * 32 + p) * LDQ + 8 * h;
        const u16* qp = Qs + (ib * 32 + p) * LDQ + 8 * h;
#pragma unroll 4
        for (int s = 0; s < 8; ++s) st = MFMA32(ld8(kp + 16 * s), ld8(qp + 16 * s), st);
      }
      const int iq = ib * 32 + p;
#pragma unroll
      for (int g = 0; g < 4; ++g) {
        float v4[4];
#pragma unroll
        for (int ii = 0; ii < 4; ++ii) {
          const int df = iq - (jb * 32 + 8 * g + 4 * h + ii);
          v4[ii] = (df >= 0) ? st[4 * g + ii] * __expf(lg * (float)df) : 0.f;
        }
        u32x2 r = {pack2(v4[0], v4[1]), pack2(v4[2], v4[3])};
        *(u32x2*)(Ps + iq * LDQ + jb * 32 + 8 * g + 4 * h) = r;
      }
    }
    __syncthreads();
#pragma unroll
    for (int a = 0; a < 4; ++a)
#pragma unroll
      for (int i = 0; i < 16; ++i) OT[a][i] = 0.f;
    {
#pragma unroll
      for (int db = 0; db < 4; ++db)
#pragma unroll
        for (int s = 0; s < 2; ++s) {
          const bf16x8 ra = pack8(R[db], s);
#pragma unroll
          for (int ib = 0; ib < 4; ++ib) {
            const u16* qp = Qs + (ib * 32 + p) * LDQ + 32 * db + 16 * s + 4 * h;
            OT[ib] = MFMA32(ra, join44(*(const u32x2*)qp, *(const u32x2*)(qp + 8)), OT[ib]);
          }
          __builtin_amdgcn_sched_barrier(0);
        }
#pragma unroll
      for (int ib = 0; ib < 4; ++ib) {
        const float qd = __expf(lg * (float)(ib * 32 + p + 1));
#pragma unroll
        for (int i = 0; i < 16; ++i) OT[ib][i] *= qd;
      }
    }
#pragma unroll
    for (int db = 0; db < 4; ++db)
#pragma unroll
      for (int i = 0; i < 16; ++i) R[db][i] *= cd;
    bf16x8 vf = ld8(vt + c * 128);
#pragma unroll 1
    for (int s = 0; s < 8; ++s) {
      bf16x8 vfn = vf;
      if (s < 7) vfn = ld8(vt + c * 128 + 16 * (s + 1));
#pragma unroll
      for (int ib = 0; ib < 4; ++ib)
        if (s <= 2 * ib + 1) OT[ib] = MFMA32(vf, ld8(Ps + (ib * 32 + p) * LDQ + 16 * s + 8 * h), OT[ib]);
#pragma unroll
      for (int db = 0; db < 4; ++db) R[db] = MFMA32(ld8(KTs + (db * 32 + p) * LDQ + 16 * s + 8 * h), vf, R[db]);
      vf = vfn;
    }
#pragma unroll
    for (int ib = 0; ib < 4; ++ib) {
      float s1 = 0.f, s2 = 0.f;
#pragma unroll
      for (int i = 0; i < 16; ++i) { s1 += OT[ib][i]; s2 += OT[ib][i] * OT[ib][i]; }
      s1 += __shfl_xor(s1, 32);
      s2 += __shfl_xor(s2, 32);
      if (h == 0) {
        stats[(w * 128 + ib * 32 + p) * 2] = s1;
        stats[(w * 128 + ib * 32 + p) * 2 + 1] = s2;
      }
    }
    __syncthreads();
    if (tid < 128) {
      float s1 = 0.f, s2 = 0.f;
#pragma unroll
      for (int ww = 0; ww < 8; ++ww) { s1 += stats[(ww * 128 + tid) * 2]; s2 += stats[(ww * 128 + tid) * 2 + 1]; }
      const float mean = s1 * (1.f / 256.f);
      const float var = fmaxf(s2 * (1.f / 256.f) - mean * mean, 0.f);
      mr[tid * 2] = mean;
      mr[tid * 2 + 1] = rsqrtf(var + LN_EPS);
    }
    __syncthreads();
    {
      u16* Ys = (u16*)smem;
#pragma unroll
      for (int ib = 0; ib < 4; ++ib) {
        const float mean = mr[(ib * 32 + p) * 2], rstd = mr[(ib * 32 + p) * 2 + 1];
        u16* yp = Ys + (ib * 32 + p) * LDQ2 + w * 32 + 4 * h;
#pragma unroll
        for (int g = 0; g < 4; ++g) {
          u32x2 r = {pack2((OT[ib][4 * g] - mean) * rstd, (OT[ib][4 * g + 1] - mean) * rstd),
                     pack2((OT[ib][4 * g + 2] - mean) * rstd, (OT[ib][4 * g + 3] - mean) * rstd)};
          *(u32x2*)(yp + 8 * g) = r;
        }
      }
      __syncthreads();
#pragma unroll 2
      for (int i = 0; i < 8; ++i) {
        const int id = tid + NTHR * i, row = id >> 5, kc = id & 31;
        u16* gp = rg + (size_t)(t0 + row) * 1024 + hd * 256 + kc * 8;
        const u32x4 sg = *(const u32x4*)gp;
        const u32x4 yv = *(const u32x4*)(Ys + row * LDQ2 + kc * 8);
        u32x4 o;
#pragma unroll
        for (int q = 0; q < 4; ++q)
          o[q] = pack2(__uint_as_float(yv[q] << 16) * __uint_as_float(sg[q] << 16),
                       __uint_as_float(yv[q] & 0xffff0000u) * __uint_as_float(sg[q] & 0xffff0000u));
        *(u32x4*)gp = o;
      }
    }
  }
}

DI void attention_item(const Params& P, char* smem, int item) {
  char* ws = launder(P.ws);
  const int tid = launder_tid(), lane = tid & 63, w = tid >> 6, h = lane >> 5, p = lane & 31;
  const int qb = 7 - (item >> 8), bh = item & 255, b = bh >> 3, h8 = bh & 7;
  float* cl = (float*)smem;
  u16* Ks = (u16*)(smem + 8192);
  u16* Vs = (u16*)(smem + 17408);
  float* wsum = (float*)(smem + 26624);
  const float* logf_ = (const float*)(ws + O_LOGF) + (size_t)bh * 2048;
  __syncthreads();
  {
    float4 a = *(const float4*)(logf_ + tid * 4);
    a.y += a.x; a.z += a.y; a.w += a.z;
    float tot = a.w;
#pragma unroll
    for (int o = 1; o < 64; o <<= 1) {
      const float n = __shfl_up(tot, o);
      if (lane >= o) tot += n;
    }
    if (lane == 63) wsum[w] = tot;
    __syncthreads();
    float off = tot - a.w;
#pragma unroll
    for (int ww = 0; ww < 8; ++ww) off += (ww < w) ? wsum[ww] : 0.f;
    a.x += off; a.y += off; a.z += off; a.w += off;
    *(float4*)(cl + tid * 4) = a;
  }
  __syncthreads();
  u16* fq = (u16*)(ws + O_FQ);
  const u16* fk = (const u16*)(ws + O_FK);
  const u16* fvt = (const u16*)(ws + O_FVT) + (size_t)(bh * 64) * 2048;
  const int qs = qb * 256 + w * 32 + p;
  const size_t qrow = (size_t)(b * 2048 + qs) * 512 + h8 * 64;
  bf16x8 qf[4];
#pragma unroll
  for (int s = 0; s < 4; ++s) qf[s] = ld8(fq + qrow + 16 * s + 8 * h);
  const float cq = cl[qs];
  f32x16 OT[2];
#pragma unroll
  for (int a = 0; a < 2; ++a)
#pragma unroll
    for (int i = 0; i < 16; ++i) OT[a][i] = 0.f;
  float m = -1e30f, l = 0.f;
  const int nkt = 4 * (qb + 1);
  const int wave_qmax = qb * 256 + w * 32 + 31;
  const int sr = tid >> 3, skc = tid & 7;
  const u16* kgp = fk + (size_t)(b * 2048 + sr) * 512 + h8 * 64 + skc * 8;
  const u16* vgp = fvt + (size_t)sr * 2048 + skc * 8;
  u32x4 kreg = *(const u32x4*)kgp;
  u32x4 vreg = *(const u32x4*)vgp;
  for (int kt = 0; kt < nkt; ++kt) {
    __syncthreads();
    *(u32x4*)(Ks + sr * LDK + skc * 8) = kreg;
    *(u32x4*)(Vs + sr * LDK + skc * 8) = vreg;
    __syncthreads();
    if (kt + 1 < nkt) {
      kreg = *(const u32x4*)(kgp + (size_t)(kt + 1) * 64 * 512);
      vreg = *(const u32x4*)(vgp + (kt + 1) * 64);
    }
    if (kt * 64 <= wave_qmax) {
      f32x16 st[2];
#pragma unroll
      for (int kb = 0; kb < 2; ++kb) {
#pragma unroll
        for (int i = 0; i < 16; ++i) st[kb][i] = 0.f;
#pragma unroll
        for (int s = 0; s < 4; ++s) {
          bf16x8 a = ld8(Ks + (kb * 32 + p) * LDK + 16 * s + 8 * h);
          st[kb] = MFMA32(a, qf[s], st[kb]);
        }
      }
      float mx = -1e30f;
#pragma unroll
      for (int kb = 0; kb < 2; ++kb)
#pragma unroll
        for (int g = 0; g < 4; ++g) {
          const int kbase = kt * 64 + kb * 32 + 8 * g + 4 * h;
          const float4 ck = *(const float4*)(cl + kbase);
          const float cks[4] = {ck.x, ck.y, ck.z, ck.w};
#pragma unroll
          for (int ii = 0; ii < 4; ++ii) {
            float v = st[kb][4 * g + ii] + cq - cks[ii];
            v = (kbase + ii <= qs) ? v : -1e30f;
            st[kb][4 * g + ii] = v;
            mx = fmaxf(mx, v);
          }
        }
      mx = fmaxf(mx, __shfl_xor(mx, 32));
      const float mn = fmaxf(m, mx);
      const float alpha = __expf(m - mn);
      m = mn;
      float ps = 0.f;
#pragma unroll
      for (int kb = 0; kb < 2; ++kb)
#pragma unroll
        for (int i = 0; i < 16; ++i) {
          const float e = __expf(st[kb][i] - mn);
          st[kb][i] = e;
          ps += e;
        }
      l = l * alpha + ps;
#pragma unroll
      for (int a = 0; a < 2; ++a)
#pragma unroll
        for (int i = 0; i < 16; ++i) OT[a][i] *= alpha;
#pragma unroll
      for (int kb = 0; kb < 2; ++kb)
#pragma unroll
        for (int s = 0; s < 2; ++s) {
          const bf16x8 pf = pack8(st[kb], s);
#pragma unroll
          for (int db = 0; db < 2; ++db) {
            const u16* vp = Vs + (db * 32 + p) * LDK + kb * 32 + 16 * s + 4 * h;
            bf16x8 a = join44(*(const u32x2*)vp, *(const u32x2*)(vp + 8));
            OT[db] = MFMA32(a, pf, OT[db]);
          }
        }
    }
  }
  l += __shfl_xor(l, 32);
  const float il = 1.f / l;
#pragma unroll
  for (int db = 0; db < 2; ++db)
#pragma unroll
    for (int g = 0; g < 4; ++g) {
      u32x2 r = {pack2(OT[db][4 * g] * il, OT[db][4 * g + 1] * il), pack2(OT[db][4 * g + 2] * il, OT[db][4 * g + 3] * il)};
      *(u32x2*)((u16*)(ws + O_YF) + qrow + db * 32 + 8 * g + 4 * h) = r;
    }
}

DI unsigned okey(float f) {
  const unsigned u = __float_as_uint(f);
  return u ^ ((unsigned)((int)u >> 31) | 0x80000000u);
}
DI float okey_inv(unsigned k) {
  const unsigned u = (k & 0x80000000u) ? (k ^ 0x80000000u) : ~k;
  return __uint_as_float(u);
}
DI void ce_desc(unsigned& a, unsigned& b) {
  const unsigned hi = max(a, b), lo = min(a, b);
  a = hi;
  b = lo;
}
DI void sort16_desc(unsigned (&a)[16]) {
#pragma unroll
  for (int k = 2; k <= 16; k <<= 1)
#pragma unroll
    for (int j = k >> 1; j > 0; j >>= 1)
#pragma unroll
      for (int i = 0; i < 16; ++i) {
        const int l = i ^ j;
        if (l > i) {
          if ((i & k) == 0) ce_desc(a[i], a[l]);
          else ce_desc(a[l], a[i]);
        }
      }
}
DI void merge_top16(unsigned (&L)[16], const unsigned (&N)[16]) {
#pragma unroll
  for (int i = 0; i < 16; ++i) L[i] = max(L[i], N[15 - i]);
#pragma unroll
  for (int j = 8; j > 0; j >>= 1)
#pragma unroll
    for (int i = 0; i < 16; ++i) {
      const int l = i ^ j;
      if (l > i) ce_desc(L[i], L[l]);
    }
}
DI void ins16(unsigned (&L)[16], unsigned x) {
#pragma unroll
  for (int i = 0; i < 16; ++i) {
    const unsigned hi = max(L[i], x);
    x = min(L[i], x);
    L[i] = hi;
  }
}

#define STAGE_SW(NT, ...)                                                               \
  {                                                                                     \
    __syncthreads();                                                                    \
    const int t_ = launder_tid(), l_ = t_ & 63, w_ = t_ >> 6;                           \
    const int wr = w_ >> 2, wc = w_ & 3, h = l_ >> 5, p = l_ & 31;                      \
    u16* T_ = (u16*)smem;                                                               \
    _Pragma("unroll") for (int mb = 0; mb < 4; ++mb) {                                  \
      const int r_ = wr * 128 + mb * 32 + p;                                            \
      _Pragma("unroll") for (int nb = 0; nb < 2; ++nb) _Pragma("unroll") for (int g = 0; g < 4; ++g) { \
        const int cl_ = wc * 64 + nb * 32 + 8 * g + 4 * h;                              \
        const int c_ = (NT) * 256 + cl_;                                                \
        float v0 = AS(nb, mb)[4 * g], v1 = AS(nb, mb)[4 * g + 1], v2 = AS(nb, mb)[4 * g + 2], v3 = AS(nb, mb)[4 * g + 3]; \
        (void)c_;                                                                       \
        __VA_ARGS__                                                                     \
        u32x2 pk_ = {pack2(v0, v1), pack2(v2, v3)};                                     \
        *(u32x2*)(T_ + r_ * LDQ2 + cl_) = pk_;                                          \
      }                                                                                 \
    }                                                                                   \
    __syncthreads();                                                                    \
  }
#define ROWS_SW(NT, ...)                                                                \
  {                                                                                     \
    const int t_ = launder_tid();                                                       \
    const u16* T_ = (const u16*)smem;                                                   \
    _Pragma("unroll 4") for (int i_ = 0; i_ < 16; ++i_) {                               \
      const int id_ = t_ + NTHR * i_, r_ = id_ >> 5, kc_ = id_ & 31;                    \
      const int c_ = (NT) * 256 + kc_ * 8;                                              \
      const u32x4 t = *(const u32x4*)(T_ + r_ * LDQ2 + kc_ * 8);                        \
      __VA_ARGS__                                                                       \
    }                                                                                   \
  }
#define BFLO(x) __uint_as_float((x) << 16)
#define BFHI(x) __uint_as_float((x) & 0xffff0000u)
DI void chain_gemms(const Params& P, char* smem, int row0) {
  char* ws = launder(P.ws);
  const u16* h0 = (const u16*)(ws + O_H0) + (size_t)row0 * 1024;
  const u16* yf = (const u16*)(ws + O_YF) + (size_t)row0 * 512;
  const u16* ar = (const u16*)(ws + O_RG) + (size_t)row0 * 1024;
  u16* merged = (u16*)(ws + O_MERGED) + (size_t)row0 * 1024;
  float* pre1 = (float*)(ws + O_PRE1) + (size_t)row0 * 1024;
  u16* gsc = (u16*)pre1;
  f32x16 acc[8];
  for (int nt = 0; nt < 4; ++nt) {
    zero_acc8(acc);
    gemm_loop<true>(h0, 1024, (const u16*)(ws + O_WGF) + (size_t)nt * 256 * 1024, 1024, 1024, smem, acc);
    STAGE_SW(nt, {
      const float4 bb = *(const float4*)(P.b_bg + 1024 + c_);
      v0 = sigmoidf_(v0 + bb.x); v1 = sigmoidf_(v1 + bb.y); v2 = sigmoidf_(v2 + bb.z); v3 = sigmoidf_(v3 + bb.w);
    })
    ROWS_SW(nt, { *(u32x4*)(merged + (size_t)r_ * 1024 + c_) = t; })
  }
  for (int nt = 0; nt < 4; ++nt) {
    zero_acc8(acc);
    gemm_loop<true>(yf, 512, (const u16*)(ws + O_WFO) + (size_t)nt * 256 * 512, 512, 512, smem, acc);
    STAGE_SW(nt, {})
    ROWS_SW(nt, {
      u32x4* mp = (u32x4*)(merged + (size_t)r_ * 1024 + c_);
      const u32x4 m = *mp;
      u32x4 o;
      _Pragma("unroll") for (int q = 0; q < 4; ++q) o[q] = pack2(BFLO(m[q]) * BFLO(t[q]), BFHI(m[q]) * BFHI(t[q]));
      *mp = o;
    })
  }
  for (int nt = 0; nt < 4; ++nt) {
    zero_acc8(acc);
    gemm_loop<true>(h0, 1024, (const u16*)(ws + O_WGR) + (size_t)nt * 256 * 1024, 1024, 1024, smem, acc);
    STAGE_SW(nt, {
      const float4 bb = *(const float4*)(P.b_bg + c_);
      v0 = sigmoidf_(v0 + bb.x); v1 = sigmoidf_(v1 + bb.y); v2 = sigmoidf_(v2 + bb.z); v3 = sigmoidf_(v3 + bb.w);
    })
    ROWS_SW(nt, { *(u32x4*)(gsc + (size_t)r_ * 1024 + c_) = t; })
  }
  for (int nt = 0; nt < 4; ++nt) {
    zero_acc8(acc);
    gemm_loop<true>(ar, 1024, (const u16*)(ws + O_WRO) + (size_t)nt * 256 * 1024, 1024, 1024, smem, acc);
    STAGE_SW(nt, {})
    ROWS_SW(nt, {
      u32x4* mp = (u32x4*)(merged + (size_t)r_ * 1024 + c_);
      const u32x4 m = *mp;
      const u32x4 gq = *(const u32x4*)(gsc + (size_t)r_ * 1024 + c_);
      u32x4 o;
      _Pragma("unroll") for (int q = 0; q < 4; ++q)
        o[q] = pack2(BFLO(m[q]) + BFLO(gq[q]) * BFLO(t[q]), BFHI(m[q]) + BFHI(gq[q]) * BFHI(t[q]));
      *mp = o;
    })
  }
  __syncthreads();
  for (int nt = 0; nt < 4; ++nt) {
    zero_acc8(acc);
    gemm_loop<true>(merged, 1024, (const u16*)(ws + O_WO) + (size_t)nt * 256 * 1024, 1024, 1024, smem, acc);
    STAGE_SW(nt, {})
    ROWS_SW(nt, {
      const u32x4 hh = *(const u32x4*)(h0 + (size_t)r_ * 1024 + c_);
      float4 y0; float4 y1;
      y0.x = ALPHA * BFLO(hh[0]) + BFLO(t[0]); y0.y = ALPHA * BFHI(hh[0]) + BFHI(t[0]);
      y0.z = ALPHA * BFLO(hh[1]) + BFLO(t[1]); y0.w = ALPHA * BFHI(hh[1]) + BFHI(t[1]);
      y1.x = ALPHA * BFLO(hh[2]) + BFLO(t[2]); y1.y = ALPHA * BFHI(hh[2]) + BFHI(t[2]);
      y1.z = ALPHA * BFLO(hh[3]) + BFLO(t[3]); y1.w = ALPHA * BFHI(hh[3]) + BFHI(t[3]);
      float* pp = pre1 + (size_t)r_ * 1024 + c_;
      *(float4*)pp = y0;
      *(float4*)(pp + 4) = y1;
    })
  }
}

DI void chain_ln1(const Params& P, char* smem, int row0) {
  char* ws = launder(P.ws);
  const int tid = launder_tid(), lane = tid & 63, w = tid >> 6, wr = w >> 1, wc = w & 1, h = lane >> 5, p = lane & 31;
  (void)wr; (void)wc; (void)h; (void)p; (void)lane; (void)w;
  float* pre1 = (float*)(ws + O_PRE1) + (size_t)row0 * 1024;
  u16* h1b = (u16*)(ws + O_H1B) + (size_t)row0 * 1024;
  unsigned char* x8 = (unsigned char*)(ws + O_X8) + (size_t)row0 * 1024;
  float4 nx[4];
#pragma unroll
  for (int q = 0; q < 4; ++q) nx[q] = *(const float4*)(pre1 + (size_t)(w * 32) * 1024 + q * 256 + lane * 4);
  for (int i = 0; i < 32; ++i) {
    const int r = w * 32 + i;
    float v[16];
    float sum = 0.f;
    float4 cx[4];
#pragma unroll
    for (int q = 0; q < 4; ++q) cx[q] = nx[q];
    if (i + 1 < 32) {
#pragma unroll
      for (int q = 0; q < 4; ++q) nx[q] = *(const float4*)(pre1 + (size_t)(r + 1) * 1024 + q * 256 + lane * 4);
    }
#pragma unroll
    for (int q = 0; q < 4; ++q) {
      float4 a = cx[q];
      v[4 * q] = a.x; v[4 * q + 1] = a.y; v[4 * q + 2] = a.z; v[4 * q + 3] = a.w;
      sum += a.x + a.y + a.z + a.w;
    }
    const float mean = wave_sum(sum) * (1.f / 1024.f);
    float sq = 0.f;
#pragma unroll
    for (int e = 0; e < 16; ++e) { v[e] -= mean; sq += v[e] * v[e]; }
    const float rstd = rsqrtf(wave_sum(sq) * (1.f / 1024.f) + LN_EPS);
#pragma unroll
    for (int q = 0; q < 4; ++q) {
      const int c = q * 256 + lane * 4;
      float4 g = *(const float4*)(P.ln1_g + c);
      float4 bb = *(const float4*)(P.ln1_b + c);
      float4 y;
      y.x = v[4 * q] * rstd * g.x + bb.x; y.y = v[4 * q + 1] * rstd * g.y + bb.y;
      y.z = v[4 * q + 2] * rstd * g.z + bb.z; y.w = v[4 * q + 3] * rstd * g.w + bb.w;
      *(float4*)(pre1 + (size_t)r * 1024 + c) = y;
      u32x2 rr = {pack2(y.x, y.y), pack2(y.z, y.w)};
      *(u32x2*)(h1b + (size_t)r * 1024 + c) = rr;
      *(unsigned*)(x8 + (size_t)r * 1024 + c) = pack_fp8x4(y.x * X_SCALE, y.y * X_SCALE, y.z * X_SCALE, y.w * X_SCALE);
    }
  }
}

DI void chain_ple(const Params& P, char* smem, int row0) {
  char* ws = launder(P.ws);
  const u16* h1b = (const u16*)(ws + O_H1B) + (size_t)row0 * 1024;
  u16* ple = (u16*)(ws + O_PLE) + (size_t)row0 * 1024;
  const u16* pb = (const u16*)(ws + O_PB) + (size_t)row0 * 256;
  f32x16 acc[8];
  for (int nt = 0; nt < 4; ++nt) {
    zero_acc8(acc);
    gemm_loop<true>(h1b, 1024, (const u16*)(ws + O_WG) + (size_t)nt * 256 * 1024, 1024, 1024, smem, acc);
    STAGE_SW(nt, {
      const float4 bb = *(const float4*)(P.b_ple_gate + c_);
      v0 = sigmoidf_(v0 + bb.x); v1 = sigmoidf_(v1 + bb.y); v2 = sigmoidf_(v2 + bb.z); v3 = sigmoidf_(v3 + bb.w);
    })
    ROWS_SW(nt, { *(u32x4*)(ple + (size_t)r_ * 1024 + c_) = t; })
  }
  for (int nt = 0; nt < 4; ++nt) {
    zero_acc8(acc);
    gemm_loop<true>(pb, 256, (const u16*)(ws + O_WPLE) + (size_t)nt * 256 * 256, 256, 256, smem, acc);
    STAGE_SW(nt, {})
    ROWS_SW(nt, {
      u32x4* mp = (u32x4*)(ple + (size_t)r_ * 1024 + c_);
      const u32x4 m = *mp;
      u32x4 o;
      _Pragma("unroll") for (int q = 0; q < 4; ++q) o[q] = pack2(BFLO(m[q]) * BFLO(t[q]), BFHI(m[q]) * BFHI(t[q]));
      *mp = o;
    })
  }
}

DI void chain_topk(const Params& P, char* smem, int row0) {
  f32x16 acc[8];
  u16* Q2 = (u16*)smem;
  u16* Kt = (u16*)(smem + 135168);
  for (int hh = 0; hh < 8; ++hh) {
    zero_acc8(acc);
    {
      char* ws0 = launder(P.ws);
      gemm_loop<true>((const u16*)(ws0 + O_H1B) + (size_t)row0 * 1024, 1024, (const u16*)(ws0 + O_WQ) + (size_t)hh * 256 * 1024, 1024, 1024, smem, acc);
    }
    char* ws = launder(P.ws);
    const int tid = launder_tid(), lane = tid & 63, w = tid >> 6, wr = w >> 2, wc = w & 3, h = lane >> 5, p = lane & 31;
    int* eidb = (int*)(ws + O_EID) + (size_t)row0 * 128;
    float* gateb = (float*)(ws + O_GATE) + (size_t)row0 * 128;
    const u16* keys = (const u16*)(ws + O_KEYS);
    __syncthreads();
#pragma unroll
    for (int mb = 0; mb < 4; ++mb)
#pragma unroll
      for (int nb = 0; nb < 2; ++nb)
#pragma unroll
        for (int g = 0; g < 4; ++g) {
          u32x2 r = {pack2(AS(nb, mb)[4 * g], AS(nb, mb)[4 * g + 1]), pack2(AS(nb, mb)[4 * g + 2], AS(nb, mb)[4 * g + 3])};
          *(u32x2*)(Q2 + (wr * 128 + mb * 32 + p) * LDQ2 + wc * 64 + nb * 32 + 8 * g + 4 * h) = r;
        }
    unsigned L0[16], L1[16];
#pragma unroll
    for (int ck = 0; ck < 4; ++ck) {
      const int c = ck >> 1, kh = ck & 1;
      __syncthreads();
#pragma unroll
      for (int i = 0; i < 2; ++i) {
        const int id = tid + NTHR * i, kr = id >> 4, kc = id & 15;
        const u32x4 v = *(const u32x4*)(keys + (size_t)((hh * 2 + c) * 128 + kh * 64 + kr) * 128 + kc * 8);
        *(u32x4*)(Kt + kr * 128 + ((kc ^ (kr & 15)) << 3)) = v;
      }
      __syncthreads();
#pragma unroll
      for (int kb2 = 0; kb2 < 2; ++kb2) {
        f32x16 sc;
#pragma unroll
        for (int i = 0; i < 16; ++i) sc[i] = 0.f;
        const int kr = kb2 * 32 + p;
#pragma unroll
        for (int s = 0; s < 8; ++s) {
          bf16x8 a = ld8(Kt + kr * 128 + (((2 * s + h) ^ (kr & 15)) << 3));
          bf16x8 bq = ld8(Q2 + (w * 32 + p) * LDQ2 + c * 128 + 16 * s + 8 * h);
          sc = MFMA32(a, bq, sc);
        }
        unsigned Nk[16];
#pragma unroll
        for (int i = 0; i < 16; ++i) {
          const int key = kh * 64 + kb2 * 32 + crow(i, h);
          Nk[i] = (okey(sc[i]) & ~127u) | (unsigned)(127 - key);
        }
        sort16_desc(Nk);
        if (kh == 0 && kb2 == 0) {
#pragma unroll
          for (int i = 0; i < 16; ++i) L1[i] = Nk[i];
        } else {
          merge_top16(L1, Nk);
        }
      }
      if (kh == 1) {
        unsigned Pn[16];
#pragma unroll
        for (int i = 0; i < 16; ++i) Pn[i] = (unsigned)__shfl_xor((int)L1[i], 32);
        merge_top16(L1, Pn);
        if (c == 0) {
#pragma unroll
          for (int i = 0; i < 16; ++i) L0[i] = L1[i];
        }
      }
    }
    {
      const int role = h;
      const int half = 0, token = w * 32 + p;
      (void)half;
      float v0[16], v1[16];
#pragma unroll
      for (int i = 0; i < 16; ++i) { v0[i] = okey_inv(L0[i] & ~127u); v1[i] = okey_inv(L1[i] & ~127u); }
      unsigned C[16];
#pragma unroll
      for (int i = 0; i < 16; ++i) C[i] = 0u;
#pragma unroll
      for (int i = 0; i < 16; ++i)
#pragma unroll
        for (int j = 0; j < 16; ++j)
          if ((i + 1) * (j + 1) <= 16) ins16(C, (okey(v0[i] + v1[j]) & ~255u) | (unsigned)(255 - (i * 16 + j)));
      float sv[16];
      int ev[16];
      const float mxs = okey_inv(C[0] & ~255u);
      float ssum = 0.f;
#pragma unroll
      for (int k = 0; k < 16; ++k) {
        const int pos = 255 - (int)(C[k] & 255u);
        const int pi = pos >> 4, pj = pos & 15;
        unsigned a0 = 0, a1 = 0;
#pragma unroll
        for (int q = 0; q < 16; ++q) { a0 = (pi == q) ? L0[q] : a0; a1 = (pj == q) ? L1[q] : a1; }
        ev[k] = (127 - (int)(a0 & 127u)) * 128 + (127 - (int)(a1 & 127u));
        sv[k] = __expf(okey_inv(C[k] & ~255u) - mxs);
        ssum += sv[k];
      }
      const float inv = 1.f / ssum;
      const size_t o = (size_t)token * 128 + hh * 16;
      if (role == 0) {
#pragma unroll
        for (int k = 0; k < 16; k += 4) {
          int4 e4 = {ev[k], ev[k + 1], ev[k + 2], ev[k + 3]};
          *(int4*)(eidb + o + k) = e4;
        }
      } else {
#pragma unroll
        for (int k = 0; k < 16; k += 4) {
          float4 g4 = {sv[k] * inv, sv[k + 1] * inv, sv[k + 2] * inv, sv[k + 3] * inv};
          *(float4*)(gateb + o + k) = g4;
        }
      }
    }
  }
}

DI float dpp_xor1(float x) {
  return __int_as_float(__builtin_amdgcn_update_dpp(0, __float_as_int(x), 0xB1, 0xF, 0xF, true));
}
DI float dpp_ror8(float x) {
  return __int_as_float(__builtin_amdgcn_update_dpp(0, __float_as_int(x), 0x128, 0xF, 0xF, true));
}
DI unsigned cvt8(u32x4 x, int lo) {
  return pack_fp8x4(__uint_as_float(x[lo] << 16) * X_SCALE, __uint_as_float(x[lo] & 0xffff0000u) * X_SCALE,
                    __uint_as_float(x[lo + 1] << 16) * X_SCALE, __uint_as_float(x[lo + 1] & 0xffff0000u) * X_SCALE);
}
DI void chain_gather(const Params& P, char* smem, int row0) {
  char* ws = launder(P.ws);
  const int tid = launder_tid(), lane = tid & 63, w = tid >> 6;
  const float* pre1 = (const float*)(ws + O_PRE1) + (size_t)row0 * 1024;
  float* outp = P.out + (size_t)row0 * 1024;
  const u16* h1b = (const u16*)(ws + O_H1B) + (size_t)row0 * 1024;
  const u16* ple = (const u16*)(ws + O_PLE) + (size_t)row0 * 1024;
  const int* eidb = (const int*)(ws + O_EID) + (size_t)row0 * 128;
  const float* gateb = (const float*)(ws + O_GATE) + (size_t)row0 * 128;
  u16* hid = (u16*)smem + w * 4096;
  u16* eid16 = (u16*)(smem + 65536) + w * 4096;
  const unsigned char* U = (const unsigned char*)(ws + O_U);
  const unsigned char* V = (const unsigned char*)(ws + O_V);
  __syncthreads();
  {
    const int4* src4 = (const int4*)(eidb + (size_t)(w * 32) * 128);
#pragma unroll 4
    for (int i = lane; i < 1024; i += 64) {
      const int4 e4 = src4[i];
      u32x2 pk = {(unsigned)e4.x | ((unsigned)e4.y << 16), (unsigned)e4.z | ((unsigned)e4.w << 16)};
      *(u32x2*)(eid16 + i * 4) = pk;
    }
  }
  {
    const int n16 = lane & 15, quad = lane >> 4, m8 = n16 >> 1, part = n16 & 1;
    const u16* ebase = eid16 + m8;
    const unsigned char* xbase = (const unsigned char*)(ws + O_X8) + (size_t)(row0 + w * 32) * 1024 + part * 64 + 16 * quad;
    const unsigned char* Ub = U + part * 64 + 16 * quad;
#define U_LOADE(ST, GO, E)                                                  \
  {                                                                         \
    const u16* er_ = ebase + ((ST) & 31) * 128 + 8 * (GO);                  \
    _Pragma("unroll") for (int g = 0; g < 8; ++g) E[g] = er_[8 * g];        \
  }
#define U_LOADR(ST, E, RA, XV)                                                         \
  {                                                                                    \
    const unsigned char* us_ = Ub + (size_t)((ST) >> 5) * 2097152;                     \
    _Pragma("unroll") for (int g = 0; g < 8; ++g) RA[g] = *(const u32x4*)(us_ + (size_t)E[g] * 128); \
    XV = *(const u32x4*)(xbase + ((ST) & 31) * 1024 + ((ST) >> 5) * 128);              \
  }
#define U_COMP(ST, GO, RA, XV)                                                                               \
  {                                                                                                          \
    const u32x2 xl_ = {XV[0], XV[1]}, xh_ = {XV[2], XV[3]};                                                  \
    const long xlo = __builtin_bit_cast(long, xl_), xhi = __builtin_bit_cast(long, xh_);                     \
    u16* hp_ = hid + ((ST) & 31) * 128 + 2 * quad + 8 * (GO);                                                \
    _Pragma("unroll") for (int g = 0; g < 8; ++g) {                                                          \
      f32x4 acc_ = (f32x4){0.f, 0.f, 0.f, 0.f};                                                              \
      const u32x2 a0_ = {RA[g][0], RA[g][1]}, a1_ = {RA[g][2], RA[g][3]};                                    \
      acc_ = __builtin_amdgcn_mfma_f32_16x16x32_fp8_fp8(__builtin_bit_cast(long, a0_), xlo, acc_, 0, 0, 0);  \
      acc_ = __builtin_amdgcn_mfma_f32_16x16x32_fp8_fp8(__builtin_bit_cast(long, a1_), xhi, acc_, 0, 0, 0);  \
      const float t1_ = dpp_xor1(acc_[1]), t3_ = dpp_xor1(acc_[3]);                                          \
      if (n16 == 0) {                                                                                        \
        float h0_ = acc_[0] + t1_, h1_ = acc_[2] + t3_;                                                      \
        if ((ST) >= 32) {                                                                                    \
          const unsigned pk_ = *(const unsigned*)(hp_ + 8 * g);                                              \
          h0_ += __uint_as_float(pk_ << 16);                                                                 \
          h1_ += __uint_as_float(pk_ & 0xffff0000u);                                                         \
        }                                                                                                    \
        *(unsigned*)(hp_ + 8 * g) = pack2(h0_, h1_);                                                         \
      }                                                                                                      \
    }                                                                                                        \
  }
    int eA[8], eB[8];
    u32x4 rA[8], rB[8], xA, xB;
    U_LOADE(0, 0, eA);
    U_LOADE(0, 8, eB);
    U_LOADR(0, eA, rA, xA);
#pragma unroll 1
    for (int st = 0; st < 256; ++st) {
      const int sn = (st + 1) & 255;
      U_LOADE(sn, 0, eA);
      U_LOADR(st, eB, rB, xB);
      U_COMP(st, 0, rA, xA);
      U_LOADE(sn, 8, eB);
      U_LOADR(sn, eA, rA, xA);
      U_COMP(st, 8, rB, xB);
    }
#undef U_LOADE
#undef U_LOADR
#undef U_COMP
#pragma unroll 4
    for (int i = 0; i < 32; ++i) {
      const float* gp = gateb + (size_t)(w * 32 + i) * 128;
#pragma unroll
      for (int hf = 0; hf < 2; ++hf) {
        const float hv = bf2f(hid[i * 128 + hf * 64 + lane]) * (1.f / (U_SCALE * X_SCALE));
        hid[i * 128 + hf * 64 + lane] = f2bf(0.5f * hv * (1.f + erff(hv * 0.7071067811865476f)) * gp[hf * 64 + lane] * (1.f / V_SCALE));
      }
    }
  }
  {
    const int rsub = lane >> 3, ch = lane & 7;
    const bool b5 = lane & 32, b4 = lane & 16, b3 = lane & 8;
    const u16* ebase = eid16 + rsub;
    const unsigned char* Vb = V + 16 * ch;
    const int colo = ch * 16 + (b5 ? 8 : 0) + (b4 ? 4 : 0) + (b3 ? 2 : 0);
#define V_LOADE(ST, IO, E)                                                        \
  {                                                                               \
    const u16* er_ = ebase + ((ST) & 31) * 128 + 8 * (IO);                        \
    _Pragma("unroll") for (int it = 0; it < 8; ++it) E[it] = er_[8 * it];         \
  }
#define V_LOADR(ST, E, R)                                                                \
  {                                                                                      \
    const unsigned char* vs_ = Vb + (size_t)((ST) >> 5) * 2097152;                       \
    _Pragma("unroll") for (int it = 0; it < 8; ++it) R[it] = *(const u32x4*)(vs_ + (size_t)E[it] * 128); \
  }
#define V_ACC(ST, IO, R)                                                                  \
  {                                                                                       \
    const u16* ap_ = hid + ((ST) & 31) * 128 + rsub + 8 * (IO);                           \
    _Pragma("unroll") for (int it = 0; it < 8; ++it) {                                    \
      const float sa = bf2f(ap_[8 * it]);                                                 \
      _Pragma("unroll") for (int q = 0; q < 4; ++q) {                                     \
        const f32v2 lo = __builtin_amdgcn_cvt_pk_f32_fp8((int)R[it][q], false);           \
        const f32v2 hi = __builtin_amdgcn_cvt_pk_f32_fp8((int)R[it][q], true);            \
        o[4 * q] += sa * lo[0];                                                           \
        o[4 * q + 1] += sa * lo[1];                                                       \
        o[4 * q + 2] += sa * hi[0];                                                       \
        o[4 * q + 3] += sa * hi[1];                                                       \
      }                                                                                   \
    }                                                                                     \
  }
    int eA[8], eB[8];
    u32x4 rA[8], rB[8];
    V_LOADE(0, 0, eA);
    V_LOADE(0, 8, eB);
    V_LOADR(0, eA, rA);
#pragma unroll 1
    for (int st = 0; st < 256; ++st) {
      float o[16];
#pragma unroll
      for (int k = 0; k < 16; ++k) o[k] = 0.f;
      const int sn = (st + 1) & 255;
      V_LOADE(sn, 0, eA);
      const size_t po = (size_t)(w * 32 + (st & 31)) * 1024 + (st >> 5) * 128 + colo;
      const float2 hv = *(const float2*)(pre1 + po);
      const unsigned pl = *(const unsigned*)(ple + po);
      V_LOADR(st, eB, rB);
      V_ACC(st, 0, rA);
      V_LOADE(sn, 8, eB);
      V_LOADR(sn, eA, rA);
      V_ACC(st, 8, rB);
      float t8[8], t4[4], t2[2];
#pragma unroll
      for (int k = 0; k < 8; ++k) {
        const float snd = b5 ? o[k] : o[8 + k];
        const float keep = b5 ? o[8 + k] : o[k];
        t8[k] = keep + __shfl_xor(snd, 32);
      }
#pragma unroll
      for (int k = 0; k < 4; ++k) {
        const float snd = b4 ? t8[k] : t8[4 + k];
        const float keep = b4 ? t8[4 + k] : t8[k];
        t4[k] = keep + __shfl_xor(snd, 16);
      }
#pragma unroll
      for (int k = 0; k < 2; ++k) {
        const float snd = b3 ? t4[k] : t4[2 + k];
        const float keep = b3 ? t4[2 + k] : t4[k];
        t2[k] = keep + dpp_ror8(snd);
      }
      float2 y;
      y.x = ALPHA * hv.x + __uint_as_float(pl << 16) + t2[0];
      y.y = ALPHA * hv.y + __uint_as_float(pl & 0xffff0000u) + t2[1];
      *(float2*)(outp + po) = y;
    }
#undef V_LOADE
#undef V_LOADR
#undef V_ACC
  }
  __syncthreads();
  float4 nx[4];
#pragma unroll
  for (int q = 0; q < 4; ++q) nx[q] = *(const float4*)(outp + (size_t)(w * 32) * 1024 + q * 256 + lane * 4);
  for (int i = 0; i < 32; ++i) {
    const int r = w * 32 + i;
    float v[16];
    float sum = 0.f;
    float4 cx[4];
#pragma unroll
    for (int q = 0; q < 4; ++q) cx[q] = nx[q];
    if (i + 1 < 32) {
#pragma unroll
      for (int q = 0; q < 4; ++q) nx[q] = *(const float4*)(outp + (size_t)(r + 1) * 1024 + q * 256 + lane * 4);
    }
#pragma unroll
    for (int q = 0; q < 4; ++q) {
      float4 a = cx[q];
      v[4 * q] = a.x; v[4 * q + 1] = a.y; v[4 * q + 2] = a.z; v[4 * q + 3] = a.w;
      sum += a.x + a.y + a.z + a.w;
    }
    const float mean = wave_sum(sum) * (1.f / 1024.f);
    float sq = 0.f;
#pragma unroll
    for (int e = 0; e < 16; ++e) { v[e] -= mean; sq += v[e] * v[e]; }
    const float rstd = rsqrtf(wave_sum(sq) * (1.f / 1024.f) + LN_EPS);
#pragma unroll
    for (int q = 0; q < 4; ++q) {
      const int c = q * 256 + lane * 4;
      float4 g = *(const float4*)(P.ln2_g + c);
      float4 bb = *(const float4*)(P.ln2_b + c);
      float4 y;
      y.x = v[4 * q] * rstd * g.x + bb.x; y.y = v[4 * q + 1] * rstd * g.y + bb.y;
      y.z = v[4 * q + 2] * rstd * g.z + bb.z; y.w = v[4 * q + 3] * rstd * g.w + bb.w;
      *(float4*)(P.out + (size_t)(row0 + r) * 1024 + c) = y;
    }
  }
}

__global__ void __launch_bounds__(NTHR) fwd_megakernel(Params P) {
  __shared__ __attribute__((aligned(16))) char smem[L_TOTAL];
  __shared__ int s_item;
  cg::grid_group grid = cg::this_grid();
  char* ws = P.ws;
  phase0(P, smem);
  for (int rb = blockIdx.x; rb < 256; rb += gridDim.x) ln_emb_rows(P, smem, rb * 256);
  grid.sync();
  {
    f32x16 acc[8];
    const bool xcd_order = gridDim.x == 256;
    const int nunits = xcd_order ? 20 : 20 * ((256 - (int)blockIdx.x + (int)gridDim.x - 1) / (int)gridDim.x);
    const int xq = blockIdx.x & 7, jq = blockIdx.x >> 3;
    for (int u = 0; u < nunits; ++u) {
      int rb, T;
      if (xcd_order) { rb = xq + 8 * (8 * (u / 5) + (jq & 7)); T = 4 * (u % 5) + (jq >> 3); }
      else { rb = blockIdx.x + (u / 20) * gridDim.x; T = u % 20; }
      const int row0 = rb * 256;
      const u16* Ablk = (const u16*)(ws + O_H0) + (size_t)row0 * 1024;
      const int ctw = T < 4 ? 2 * T : 2 * T - 4;
      const u16* Bt = (const u16*)(ws + O_WIN) + (size_t)ctw * 128 * 1024;
      const bool sw = T < 4 || (T >= 10 && T < 18);
      zero_acc8(acc);
      if (sw) gemm_loop<true>(Ablk, 1024, Bt, 1024, 1024, smem, acc);
      else gemm_loop<false>(Ablk, 1024, Bt, 1024, 1024, smem, acc);
      p1_epilogue(P, T, row0, smem, acc);
    }
  }
  grid.sync();
  if (threadIdx.x == 0) s_item = atomicAdd((int*)(ws + O_CTR), 1);
  while (true) {
    __syncthreads();
    const int item = s_item;
    __syncthreads();
    if (item >= 128 + 2048) break;
    int nxt = 0;
    if (threadIdx.x == 0) nxt = atomicAdd((int*)(ws + O_CTR), 1);
    if (item < 128) retention_item(P, smem, item);
    else attention_item(P, smem, item - 128);
    if (threadIdx.x == 0) s_item = nxt;
  }
  grid.sync();
  for (int rb = blockIdx.x; rb < 256; rb += gridDim.x) {
    const int row0 = rb * 256;
    chain_gemms(P, smem, row0);
    __syncthreads();
    chain_ln1(P, smem, row0);
    __syncthreads();
    chain_ple(P, smem, row0);
    chain_topk(P, smem, row0);
  }
  __syncthreads();
  for (int rb = blockIdx.x; rb < 256; rb += gridDim.x) chain_gather(P, smem, rb * 256);
}

extern "C" void kernel_launch(void* const* d_in, const int* in_sizes, int n_in, void* d_out, int out_size, void* d_ws,
                              size_t ws_size, hipStream_t stream) {
  static int grid_blocks = 0;
  if (!grid_blocks) {
    int dev = 0, cus = 0, per_cu = 0;
    hipGetDevice(&dev);
    hipDeviceGetAttribute(&cus, hipDeviceAttributeMultiprocessorCount, dev);
    hipOccupancyMaxActiveBlocksPerMultiprocessor(&per_cu, fwd_megakernel, NTHR, 0);
    if (per_cu > 1) per_cu = 1;
    grid_blocks = cus * per_cu;
    if (grid_blocks > 256) grid_blocks = 256;
  }
  Params p{};
  const float** fp = (const float**)&p;
  for (int i = 0; i < 21; ++i) fp[i] = (const float*)d_in[i];
  p.out = (float*)d_out;
  p.ws = (char*)d_ws;
  void* args[] = {&p};
  hipError_t e = hipLaunchCooperativeKernel((void*)fwd_megakernel, dim3(grid_blocks), dim3(NTHR), args, 0, stream);
  if (e != hipSuccess) fprintf(stderr, "cooperative launch failed: %s (grid %d)\n", hipGetErrorString(e), grid_blocks);
}
```
